# Optimizing an MI355X kernel written in HIP

```python
import math
import jax, jax.numpy as jnp
from jax import lax
import numpy as np

D_MODEL = 1024
BATCH = 8
SEQ = 4096
DEPTH = 2

F32 = jnp.float32
EPS = 1e-6
NEG_INF = -1e30
ROPE_THETA = 10000.0
BLOCK = 128
HEAD_DIM = 64

SWA_HEADS = 8
SWA_KV_HEADS = 2
SWA_WINDOW = 128
S5_CHANNELS = 512
S5_GROUP = 16
S5_GROUPS = S5_CHANNELS // S5_GROUP
S5_STATE = 64
S5_DT_MIN = 1e-3
S5_DT_MAX = 1e-1
RET_HEADS = 4
RET_QK_DIM = 64
RET_V_DIM = 128
RET_CHUNK = 128
MLA_HEADS = 8
MLA_Q_RANK = 256
MLA_KV_RANK = 128
MLA_NOPE_DIM = 64
MLA_ROPE_DIM = 32
MLA_V_DIM = 64
N_BRANCH = 4
BRANCH_WIDTH = 512
D_FF = 4 * D_MODEL

SWA_Q_W = SWA_HEADS * HEAD_DIM
SWA_KV_W = SWA_KV_HEADS * HEAD_DIM
RET_QK_W = RET_HEADS * RET_QK_DIM
RET_V_W = RET_HEADS * RET_V_DIM
IN_SPLITS = (SWA_Q_W, SWA_KV_W, SWA_KV_W,
             S5_CHANNELS,
             RET_QK_W, RET_QK_W, RET_V_W, RET_V_W,
             MLA_Q_RANK, MLA_KV_RANK, MLA_ROPE_DIM,
             N_BRANCH * D_MODEL)
D_IN = sum(IN_SPLITS)

kernel_name = "hybrid_gated_swa_s5_retnet_mla_block"


def rms_norm(x, g):
    xf = x.astype(F32)
    y = xf * lax.rsqrt(jnp.mean(xf * xf, axis=-1, keepdims=True) + EPS)
    return (y * g.astype(F32)).astype(x.dtype)


def rope_tables(seq, dim):
    inv = 1.0 / (ROPE_THETA ** (jnp.arange(0, dim, 2, dtype=F32) / dim))
    ang = jnp.arange(seq, dtype=F32)[:, None] * inv[None, :]
    return jnp.cos(ang), jnp.sin(ang)


def apply_rope(x, cos, sin):
    xf = x.astype(F32)
    x1, x2 = jnp.split(xf, 2, axis=-1)
    c = cos[None, :, None, :]
    s = sin[None, :, None, :]
    return jnp.concatenate([x1 * c - x2 * s, x2 * c + x1 * s], axis=-1).astype(x.dtype)


def swa_attention(q, k, v, sinks):
    b, s_len, h, d = q.shape
    nb = s_len // BLOCK
    grp = h // SWA_KV_HEADS
    qb = q.reshape(b, nb, BLOCK, SWA_KV_HEADS, grp, d)

    def with_prev(t):
        tb = t.reshape(b, nb, BLOCK, SWA_KV_HEADS, d)
        prev = jnp.pad(tb[:, :-1], ((0, 0), (1, 0), (0, 0), (0, 0), (0, 0)))
        return jnp.concatenate([prev, tb], axis=2)

    kb, vb = with_prev(k), with_prev(v)
    sc = jnp.einsum('bnqkgd,bnckd->bnkgqc', qb, kb, preferred_element_type=F32) * (d ** -0.5)
    qi = jnp.arange(BLOCK)[:, None] + BLOCK
    kj = jnp.arange(2 * BLOCK)[None, :]
    diff = qi - kj
    band = (diff >= 0) & (diff < SWA_WINDOW)
    has_prev = (jnp.arange(nb) > 0)[:, None, None] | (kj >= BLOCK)[None]
    mask = (band[None] & has_prev)[None, :, None, None]
    sc = jnp.where(mask, sc, NEG_INF)
    sink = sinks.astype(F32).reshape(1, 1, SWA_KV_HEADS, grp, 1, 1)
    m = jnp.maximum(jnp.max(sc, axis=-1, keepdims=True), sink)
    p = jnp.exp(sc - m)
    denom = jnp.sum(p, axis=-1, keepdims=True) + jnp.exp(sink - m)
    o = jnp.einsum('bnkgqc,bnckd->bnqkgd', (p / denom).astype(v.dtype), vb)
    return o.reshape(b, s_len, h * d)


def s5_ssm(u, lam_re, lam_im, log_dt, b_re, b_im, c_re, c_im, d_skip, w_glu):
    b, s_len, _ = u.shape
    uf = u.astype(F32).reshape(b, s_len, S5_GROUPS, S5_GROUP)
    dt = jnp.exp(log_dt.astype(F32))[:, None]
    lr, li = lam_re.astype(F32), lam_im.astype(F32)
    mag = jnp.exp(lr * dt)
    ab_re, ab_im = mag * jnp.cos(li * dt), mag * jnp.sin(li * dt)
    den = lr * lr + li * li
    nr, ni = ab_re - 1.0, ab_im
    f_re = (nr * lr + ni * li) / den
    f_im = (ni * lr - nr * li) / den
    br, bi = b_re.astype(F32), b_im.astype(F32)
    bb_re = f_re[..., None] * br - f_im[..., None] * bi
    bb_im = f_re[..., None] * bi + f_im[..., None] * br
    bu_re = jnp.einsum('bsgc,gpc->bsgp', uf, bb_re)
    bu_im = jnp.einsum('bsgc,gpc->bsgp', uf, bb_im)
    a_re = jnp.broadcast_to(ab_re, bu_re.shape)
    a_im = jnp.broadcast_to(ab_im, bu_im.shape)

    def combine(left, right):
        a1r, a1i, b1r, b1i = left
        a2r, a2i, b2r, b2i = right
        return (a1r * a2r - a1i * a2i, a1r * a2i + a1i * a2r,
                a2r * b1r - a2i * b1i + b2r, a2r * b1i + a2i * b1r + b2i)

    _, _, x_re, x_im = lax.associative_scan(combine, (a_re, a_im, bu_re, bu_im), axis=1)
    y = (jnp.einsum('bsgp,gcp->bsgc', x_re, c_re.astype(F32))
         - jnp.einsum('bsgp,gcp->bsgc', x_im, c_im.astype(F32)))
    y = y.reshape(b, s_len, S5_CHANNELS) + d_skip.astype(F32) * u.astype(F32)
    z = jax.nn.gelu(y).astype(u.dtype)
    za, zb = jnp.split(z @ w_glu, 2, axis=-1)
    return za * jax.nn.sigmoid(zb)


def retention(q, k, v, g, cos, sin):
    b, s_len, h, dk = q.shape
    dv = v.shape[-1]
    c = RET_CHUNK
    nc = s_len // c
    qf = apply_rope(q, cos, sin).astype(F32)
    kf = apply_rope(k, cos, sin).astype(F32) * (dk ** -0.5)
    qc = qf.reshape(b, nc, c, h, dk)
    kc = kf.reshape(b, nc, c, h, dk)
    vc = v.astype(F32).reshape(b, nc, c, h, dv)
    log_gamma = jnp.log1p(-jnp.exp2(-5.0 - jnp.arange(h, dtype=F32)))
    idx = jnp.arange(c, dtype=F32)
    diff = idx[:, None] - idx[None, :]
    decay = jnp.where(diff >= 0, jnp.exp(log_gamma[:, None, None] * jnp.maximum(diff, 0.0)), 0.0)
    inner_s = jnp.einsum('bnqhd,bnkhd->bnhqk', qc, kc) * decay
    inner = jnp.einsum('bnhqk,bnkhe->bnqhe', inner_s, vc)
    k_w = jnp.exp(log_gamma[None, :] * (c - 1 - idx)[:, None])
    upd = jnp.einsum('bnkhd,bnkhe->bnhde', kc * k_w[None, None, :, :, None], vc)
    chunk_decay = jnp.exp(log_gamma * c)[None, :, None, None]

    def step(state, u_n):
        return state * chunk_decay + u_n, state

    _, prev = lax.scan(step, jnp.zeros((b, h, dk, dv), F32), jnp.moveaxis(upd, 1, 0))
    prev = jnp.moveaxis(prev, 0, 1)
    q_w = jnp.exp(log_gamma[None, :] * (idx + 1.0)[:, None])
    cross = jnp.einsum('bnqhd,bnhde->bnqhe', qc * q_w[None, None, :, :, None], prev)
    y = (inner + cross).reshape(b, s_len, h, dv)
    mu = jnp.mean(y, axis=-1, keepdims=True)
    var = jnp.mean(jnp.square(y - mu), axis=-1, keepdims=True)
    y = ((y - mu) * lax.rsqrt(var + EPS)).reshape(b, s_len, h * dv)
    return (jax.nn.silu(g.astype(F32)) * y).astype(v.dtype)


def mla_attention(c_q, c_kv, k_rope, g_q, g_kv, w_uq, w_ukv, cos, sin):
    b, s_len, _ = c_q.shape
    h = MLA_HEADS
    q = (rms_norm(c_q, g_q) @ w_uq).reshape(b, s_len, h, MLA_NOPE_DIM + MLA_ROPE_DIM)
    q_nope = q[..., :MLA_NOPE_DIM]
    q_rope = apply_rope(q[..., MLA_NOPE_DIM:], cos, sin)
    kv = (rms_norm(c_kv, g_kv) @ w_ukv).reshape(b, s_len, h, MLA_NOPE_DIM + MLA_V_DIM)
    k_nope, v = kv[..., :MLA_NOPE_DIM], kv[..., MLA_NOPE_DIM:]
    k_r = apply_rope(k_rope[:, :, None, :], cos, sin)[:, :, 0]
    scale = (MLA_NOPE_DIM + MLA_ROPE_DIM) ** -0.5
    nb = s_len // BLOCK
    qn_b = jnp.moveaxis(q_nope.reshape(b, nb, BLOCK, h, MLA_NOPE_DIM), 1, 0)
    qr_b = jnp.moveaxis(q_rope.reshape(b, nb, BLOCK, h, MLA_ROPE_DIM), 1, 0)
    kpos = jnp.arange(s_len)

    def one_block(args):
        qn, qr, i = args
        sc = (jnp.einsum('bqhd,bkhd->bhqk', qn, k_nope, preferred_element_type=F32)
              + jnp.einsum('bqhd,bkd->bhqk', qr, k_r, preferred_element_type=F32)) * scale
        qpos = i * BLOCK + jnp.arange(BLOCK)
        sc = jnp.where(kpos[None, :] <= qpos[:, None], sc, NEG_INF)
        p = jax.nn.softmax(sc, axis=-1).astype(v.dtype)
        return jnp.einsum('bhqk,bkhe->bqhe', p, v)

    o = lax.map(one_block, (qn_b, qr_b, jnp.arange(nb)))
    return jnp.moveaxis(o, 0, 1).reshape(b, s_len, h * MLA_V_DIM)


def setup_inputs(seed: int = 0) -> dict:
    key = jax.random.key(seed)
    ks = jax.random.split(key, 32)
    L = DEPTH

    def nrm(k, shape, scale):
        return jax.random.normal(k, shape, F32) * scale

    def gain(k, shape):
        return 1.0 + 0.05 * jax.random.normal(k, shape, F32)

    n_idx = jnp.arange(S5_STATE, dtype=F32)
    return {
        "x": jax.random.normal(ks[0], (BATCH, SEQ, D_MODEL), F32),
        "g_pre_mix": gain(ks[1], (L, D_MODEL)),
        "g_post_mix": gain(ks[2], (L, D_MODEL)),
        "g_pre_mlp": gain(ks[3], (L, D_MODEL)),
        "g_post_mlp": gain(ks[4], (L, D_MODEL)),
        "w_in": nrm(ks[5], (L, D_MODEL, D_IN), D_MODEL ** -0.5),
        "swa_sinks": nrm(ks[6], (L, SWA_HEADS), 0.5),
        "s5_lam_re": -0.5 + 0.01 * jax.random.normal(ks[7], (L, S5_GROUPS, S5_STATE), F32),
        "s5_lam_im": math.pi * n_idx + 0.01 * jax.random.normal(ks[8], (L, S5_GROUPS, S5_STATE), F32),
        "s5_log_dt": jax.random.uniform(ks[9], (L, S5_GROUPS), F32, math.log(S5_DT_MIN), math.log(S5_DT_MAX)),
        "s5_b_re": nrm(ks[10], (L, S5_GROUPS, S5_STATE, S5_GROUP), (2 * S5_GROUP) ** -0.5),
        "s5_b_im": nrm(ks[11], (L, S5_GROUPS, S5_STATE, S5_GROUP), (2 * S5_GROUP) ** -0.5),
        "s5_c_re": nrm(ks[12], (L, S5_GROUPS, S5_GROUP, S5_STATE), (2 * S5_STATE) ** -0.5),
        "s5_c_im": nrm(ks[13], (L, S5_GROUPS, S5_GROUP, S5_STATE), (2 * S5_STATE) ** -0.5),
        "s5_d": nrm(ks[14], (L, S5_CHANNELS), 1.0),
        "s5_w_glu": nrm(ks[15], (L, S5_CHANNELS, 2 * S5_CHANNELS), S5_CHANNELS ** -0.5),
        "mla_g_q": gain(ks[16], (L, MLA_Q_RANK)),
        "mla_g_kv": gain(ks[17], (L, MLA_KV_RANK)),
        "mla_w_uq": nrm(ks[18], (L, MLA_Q_RANK, MLA_HEADS * (MLA_NOPE_DIM + MLA_ROPE_DIM)), MLA_Q_RANK ** -0.5),
        "mla_w_ukv": nrm(ks[19], (L, MLA_KV_RANK, MLA_HEADS * (MLA_NOPE_DIM + MLA_V_DIM)), MLA_KV_RANK ** -0.5),
        "w_branch": nrm(ks[20], (L, N_BRANCH, BRANCH_WIDTH, D_MODEL), BRANCH_WIDTH ** -0.5),
        "w_out": nrm(ks[21], (L, D_MODEL, D_MODEL), D_MODEL ** -0.5),
        "w_ff1": nrm(ks[22], (L, D_MODEL, D_FF), D_MODEL ** -0.5),
        "w_ff2": nrm(ks[23], (L, D_FF, D_MODEL), D_FF ** -0.5),
    }


def reference(x, g_pre_mix, g_post_mix, g_pre_mlp, g_post_mlp, w_in, swa_sinks,
              s5_lam_re, s5_lam_im, s5_log_dt, s5_b_re, s5_b_im, s5_c_re, s5_c_im,
              s5_d, s5_w_glu, mla_g_q, mla_g_kv, mla_w_uq, mla_w_ukv,
              w_branch, w_out, w_ff1, w_ff2):
    b, s_len, _ = x.shape
    cos_h, sin_h = rope_tables(s_len, HEAD_DIM)
    cos_r, sin_r = rope_tables(s_len, MLA_ROPE_DIM)
    split_at = tuple(int(i) for i in np.cumsum(IN_SPLITS)[:-1])
    for l in range(DEPTH):
        h = rms_norm(x, g_pre_mix[l])
        (sq, sk, sv, su, rq, rk, rv, rg, cq, ckv, kr, gate_logits) = jnp.split(h @ w_in[l], split_at, axis=-1)
        y_a = swa_attention(
            apply_rope(sq.reshape(b, s_len, SWA_HEADS, HEAD_DIM), cos_h, sin_h),
            apply_rope(sk.reshape(b, s_len, SWA_KV_HEADS, HEAD_DIM), cos_h, sin_h),
            sv.reshape(b, s_len, SWA_KV_HEADS, HEAD_DIM), swa_sinks[l])
        y_b = s5_ssm(su, s5_lam_re[l], s5_lam_im[l], s5_log_dt[l], s5_b_re[l], s5_b_im[l],
                     s5_c_re[l], s5_c_im[l], s5_d[l], s5_w_glu[l])
        y_c = retention(rq.reshape(b, s_len, RET_HEADS, RET_QK_DIM),
                        rk.reshape(b, s_len, RET_HEADS, RET_QK_DIM),
                        rv.reshape(b, s_len, RET_HEADS, RET_V_DIM), rg, cos_h, sin_h)
        y_d = mla_attention(cq, ckv, kr, mla_g_q[l], mla_g_kv[l], mla_w_uq[l], mla_w_ukv[l], cos_r, sin_r)
        gates = jax.nn.sigmoid(gate_logits.astype(F32)).astype(x.dtype).reshape(b, s_len, N_BRANCH, D_MODEL)
        merged = (gates[:, :, 0] * (y_a @ w_branch[l, 0])
                  + gates[:, :, 1] * (y_b @ w_branch[l, 1])
                  + gates[:, :, 2] * (y_c @ w_branch[l, 2])
                  + gates[:, :, 3] * (y_d @ w_branch[l, 3]))
        x = x + rms_norm(merged @ w_out[l], g_post_mix[l])
        h = rms_norm(x, g_pre_mlp[l])
        f = jnp.square(jax.nn.relu(h @ w_ff1[l])) @ w_ff2[l]
        x = x + rms_norm(f, g_post_mlp[l])
    return x
```

```cpp
#include <hip/hip_runtime.h>
#include <hip/hip_cooperative_groups.h>
#include <cstdio>
#include <cstdint>
namespace cg = cooperative_groups;

#ifndef N_LAUNCH_MODE
#define N_LAUNCH_MODE 1
#endif

#ifndef PROBE_SKIP
#define PROBE_SKIP 0
#endif
#ifndef PROBE_PRE
#define PROBE_PRE 0
#endif

#define LAS __attribute__((address_space(3)))
#define DI __device__ __forceinline__
typedef unsigned short bf16_t;
typedef short bf16x8 __attribute__((ext_vector_type(8)));
typedef float f32x4 __attribute__((ext_vector_type(4)));
typedef float f32x16 __attribute__((ext_vector_type(16)));
typedef unsigned u32x4 __attribute__((ext_vector_type(4)));
typedef unsigned u32x2 __attribute__((ext_vector_type(2)));

constexpr int M = 32768, SEQ = 4096, NBATCH = 8, DM = 1024, DFF = 4096, DIN = 7328;
constexpr int HP = 4096 + 64;
constexpr int PP = 3328;
constexpr int C_SQ = 0, C_SK = 512, C_SV = 640, C_U = 768, C_RQ = 1280, C_RK = 1536, C_RV = 1792, C_RG = 2304, C_CQ = 2816, C_CKV = 3072, C_KR = 3200;
constexpr float EPS = 1e-6f;
constexpr float LOG2E = 1.4426950408889634f;

constexpr size_t MiB = 1u << 20;
constexpr size_t W_IN = 0, W_GATE = W_IN + (size_t)3328 * 1024 * 2, W_GLU = W_GATE + (size_t)4096 * 1024 * 2, W_UQ = W_GLU + (size_t)1024 * 512 * 2,
                 W_UKV = W_UQ + (size_t)768 * 256 * 2, W_BR = W_UKV + (size_t)1024 * 128 * 2, W_OUT = W_BR + (size_t)4 * 1024 * 512 * 2,
                 W_FF1 = W_OUT + (size_t)1024 * 1024 * 2, W_FF2 = W_FF1 + (size_t)4096 * 1024 * 2, W_END = W_FF2 + (size_t)HP * 1024 * 2;
static_assert(W_END <= 40 * MiB, "weights");
constexpr size_t OFF_ROPEH = 40 * MiB, OFF_ROPER = 41 * MiB, OFF_XN = 43 * MiB, OFF_P = 107 * MiB, OFF_QM = 315 * MiB, OFF_KV = 363 * MiB,
                 OFF_RS = 427 * MiB, OFF_LE = 459 * MiB, OFF_TZ = 475 * MiB, OFF_MC = 491 * MiB, OFF_WST = 495 * MiB, OFF_AT = 499 * MiB, OFF_SSQ = 500 * MiB, OFF_BAR = 508 * MiB, WS_NEED = 509 * MiB;
constexpr size_t OFF_PV = OFF_RS + 16 * MiB;
constexpr size_t OFF_XP = OFF_LE + 8 * MiB;
constexpr size_t OFF_SCR = OFF_RS;

struct Args {
    const float* in[24];
    float* out; unsigned char* ws;
    int ph_lo, ph_hi;
};

typedef float f32x2_t __attribute__((ext_vector_type(2))); typedef __bf16 bf16x2_t __attribute__((ext_vector_type(2)));
DI unsigned pk2(float lo, float hi) { f32x2_t v = {lo, hi}; bf16x2_t b = __builtin_convertvector(v, bf16x2_t); return __builtin_bit_cast(unsigned, b); }
DI unsigned f2bf(float f) { return pk2(f, 0.f) & 0xffffu; }
DI float bflo(unsigned w) { return __builtin_bit_cast(float, w << 16); }
DI float bfhi(unsigned w) { return __builtin_bit_cast(float, w & 0xffff0000u); }
DI float bf2f(bf16_t b) { return __builtin_bit_cast(float, (unsigned)b << 16); }
DI float ex2(float x) { return __builtin_amdgcn_exp2f(x); }
DI float sigmoidf_(float x) { return __builtin_amdgcn_rcpf(1.f + ex2(-x * LOG2E)); }
DI int crow(int r, int hi) { return (r & 3) + 8 * (r >> 2) + 4 * hi; }
DI float wave_sum(float v) {
#pragma unroll
    for (int o = 1; o < 64; o <<= 1) v += __shfl_xor(v, o);
    return v;
}
#define MFMA32(a, b, c) __builtin_amdgcn_mfma_f32_32x32x16_bf16((a), (b), (c), 0, 0, 0)
DI bf16x8 packp(const f32x16& p, int base) {
    u32x4 w; w.x = pk2(p[base + 0], p[base + 1]); w.y = pk2(p[base + 2], p[base + 3]); w.z = pk2(p[base + 4], p[base + 5]); w.w = pk2(p[base + 6], p[base + 7]);
    return __builtin_bit_cast(bf16x8, w);
}
DI int vpos(int kv) { const int t = kv & 15; return (kv & ~15) + 8 * ((t >> 2) & 1) + 4 * (t >> 3) + (t & 3); }

extern __shared__ __attribute__((aligned(16))) unsigned char lds_raw[];
constexpr int TIDTAB_OFF = 131072 + 1280;
DI unsigned hw_wave_slot() { return (unsigned)__builtin_amdgcn_s_getreg((5 << 11) | 4) & 63u; }
DI int my_tid() {
    const int w = *(volatile LAS int*)((LAS unsigned char*)lds_raw + TIDTAB_OFF + hw_wave_slot() * 4);
    unsigned ones = ~0u; asm volatile("" : "+s"(ones));
    return __builtin_amdgcn_readfirstlane(w) * 64 + (int)__builtin_amdgcn_mbcnt_hi(ones, __builtin_amdgcn_mbcnt_lo(ones, 0u));
}

namespace eng {
constexpr int BM = 256, BK = 64, HALF = 128, HTB = HALF * BK * 2, STAGE_BYTES = 8 * HTB, NXCD = 8, WGM = 8;
DI int lds_byte(int r, int c) { const int st = (r >> 4) * 2 + (c >> 5), rr = r & 15, cc = c & 31, ob = rr * 64 + cc * 2; return st * 1024 + (ob ^ (((ob >> 9) & 1) << 5)); }
DI void stage_rc(int b, int& R, int& C) { const int st = b / 1024, sb = b % 1024, swz = sb ^ (((sb >> 9) & 1) << 5); R = (st >> 1) * 16 + swz / 64; C = (st & 1) * 32 + (swz % 64) / 2; }
DI int perm32(int rho) { const int n = rho >> 4, i = rho & 15; return 8 * (i >> 2) + 4 * n + (i & 3); }

struct Unit { const char* A; const char* B; int ldaB, kB, nt, pm, pn, tag, ksA; };

DI bool tile_of(int i, int G, int c, int nM, int nN, int& pm, int& pn) {
    const int nwg = nM * nN; const long L = (long)i * G + c; if (L >= nwg) return false;
    int wgid = (int)L; { const int q = nwg / NXCD, r = nwg % NXCD, xcd = wgid % NXCD, off = wgid / NXCD; wgid = (xcd < r ? xcd * (q + 1) : r * (q + 1) + (xcd - r) * q) + off; }
    const int nig = WGM * nN, gid = wgid / nig, fm = gid * WGM, gsz = (nM - fm) < WGM ? (nM - fm) : WGM;
    pm = fm + ((wgid % nig) % gsz); pn = (wgid % nig) / gsz; return true;
}
struct PlainSched {
    const char* A; const char* B; int ldaB, kB, nt, nM, nN, G, c; int ksA; size_t tileA;
    DI bool next(int i, Unit& u) const {
        int pm, pn; if (!tile_of(i, G, c, nM, nN, pm, pn)) return false;
        u.pm = pm; u.pn = pn; u.tag = 0; u.ldaB = ldaB; u.kB = kB; u.nt = nt; u.ksA = ksA; u.A = A + (size_t)pm * tileA; u.B = B + (size_t)pn * 256 * kB; return true;
    }
};

template <bool ALIGN = true, class Epi, class Sched>
DI void gemm_phase(LAS unsigned char* lds, const Sched& S, const Epi& E) {
    int tid = my_tid(); asm volatile("" : "+v"(tid));
    const int wid = __builtin_amdgcn_readfirstlane(tid >> 6), lane = tid & 63, wr = wid >> 2, wc = wid & 3, fr = lane & 15, fq = lane >> 4;
    int R0, C0; stage_rc(tid * 16, R0, C0);
    const int Rb0 = (R0 & ~31) + perm32(R0 & 31);
    const unsigned ldsw = (unsigned)wid * 1024u;
    const int aoff = lds_byte(wr * 64 + fr, fq * 8), boff = lds_byte(wc * 32 + fr, fq * 8);
    constexpr size_t kstep = (size_t)(BK * 2);
#define PG8_SA(b, h) (((b) * 2 + (h)) * HTB)
#define PG8_SB(b, h) ((4 + (b) * 2 + (h)) * HTB)
#define PG8_STAGE(bufoff, gbase, v0, s64) do { \
        __builtin_amdgcn_global_load_lds((const unsigned*)((const char*)(gbase) + (v0)), (LAS unsigned*)(lds + (bufoff) + ldsw), 16, 0, 0); \
        __builtin_amdgcn_global_load_lds((const unsigned*)((const char*)(gbase) + (v0) + (s64)), (LAS unsigned*)(lds + (bufoff) + ldsw + 8192), 16, 0, 0); } while (0)
#define PG8_LDA(dst, b, h) do { _Pragma("unroll") for (int m = 0; m < 4; ++m) _Pragma("unroll") for (int k = 0; k < 2; ++k) dst[m][k] = *(const LAS bf16x8*)(lds + PG8_SA(b, h) + aoff + m * 2048 + k * 1024); } while (0)
#define PG8_LDB(dst, b, h) do { _Pragma("unroll") for (int n = 0; n < 2; ++n) _Pragma("unroll") for (int k = 0; k < 2; ++k) dst[n][k] = *(const LAS bf16x8*)(lds + PG8_SB(b, h) + boff + n * 2048 + k * 1024); } while (0)
#define PG8_MMA(ai, bj, At, Bt) do { __builtin_amdgcn_s_setprio(1); _Pragma("unroll") for (int m = 0; m < 4; ++m) _Pragma("unroll") for (int n = 0; n < 2; ++n) _Pragma("unroll") for (int k = 0; k < 2; ++k) \
        acc[ai][bj][m][n] = __builtin_amdgcn_mfma_f32_16x16x32_bf16(Bt[n][k], At[m][k], acc[ai][bj][m][n], 0, 0, 0); __builtin_amdgcn_s_setprio(0); } while (0)
#define PG8_WAIT_V(n) asm volatile("s_waitcnt vmcnt(" #n ")" ::: "memory")
#define PG8_WAIT_L(n) asm volatile("s_waitcnt lgkmcnt(" #n ")" ::: "memory")
#define PG8_BAR __builtin_amdgcn_s_barrier()
#define PG8_SCHED __builtin_amdgcn_sched_barrier(0)
    Unit cur, nxt; int ui = 0;
    if (!S.next(0, cur)) return;
    f32x4 acc[2][2][4][2];
#pragma unroll
    for (int a = 0; a < 2; ++a)
#pragma unroll
        for (int b = 0; b < 2; ++b)
#pragma unroll
            for (int m = 0; m < 4; ++m)
#pragma unroll
                for (int n = 0; n < 2; ++n) acc[a][b][m][n] = (f32x4){0.f, 0.f, 0.f, 0.f};
    bf16x8 At[4][2], B0[2][2], B1[2][2];
    const char* cA = cur.A; const char* cB = cur.B;
    unsigned vA = (unsigned)(R0 * cur.ldaB + C0 * 2), vB = (unsigned)(Rb0 * cur.kB + C0 * 2), sA = (unsigned)(64 * cur.ldaB), sB = (unsigned)(64 * cur.kB);
    {
        const size_t hA = 2 * (size_t)sA, hB = 2 * (size_t)sB;
        PG8_STAGE(PG8_SB(0, 0), cB, vB, sB); PG8_STAGE(PG8_SB(0, 1), cB + hB, vB, sB); PG8_STAGE(PG8_SA(0, 0), cA, vA, sA); PG8_STAGE(PG8_SA(0, 1), cA + hA, vA, sA);
        if (wr == 1) PG8_BAR;
        PG8_WAIT_V(2); PG8_BAR;
        PG8_STAGE(PG8_SB(1, 0), cB + kstep, vB, sB); PG8_STAGE(PG8_SA(1, 0), cA + cur.ksA, vA, sA); PG8_STAGE(PG8_SB(1, 1), cB + hB + kstep, vB, sB);
        PG8_WAIT_V(6); PG8_BAR;
    }
    for (;;) {
        const bool has_next = S.next(ui + 1, nxt);
        const char* nA = has_next ? nxt.A : cA; const char* nB = has_next ? nxt.B : cB;
        const unsigned nvA = has_next ? (unsigned)(R0 * nxt.ldaB + C0 * 2) : vA, nvB = has_next ? (unsigned)(Rb0 * nxt.kB + C0 * 2) : vB;
        const unsigned nsA = has_next ? (unsigned)(64 * nxt.ldaB) : sA, nsB = has_next ? (unsigned)(64 * nxt.kB) : sB;
        const int nt = cur.nt; const size_t hA = 2 * (size_t)sA; const size_t ksA = (size_t)cur.ksA, nksA = has_next ? (size_t)nxt.ksA : ksA;
        for (int t = 0; t < nt; t += 2) {
            const bool last = (t == nt - 2);
            const char* a1 = cA + (size_t)(t + 1) * ksA;
            const char* a2 = last ? nA : cA + (size_t)(t + 2) * ksA; const char* b2 = last ? nB : cB + (size_t)(t + 2) * kstep;
            const char* a3 = a2 + (last ? nksA : ksA); const char* b3 = b2 + kstep;
            const unsigned vA2 = last ? nvA : vA, vB2 = last ? nvB : vB, sA2 = last ? nsA : sA, sB2 = last ? nsB : sB;
            const size_t hA2 = 2 * (size_t)sA2, hB2 = 2 * (size_t)sB2;
            PG8_LDB(B0, 0, 0); PG8_LDB(B1, 0, 1); PG8_SCHED; PG8_LDA(At, 0, 0); PG8_STAGE(PG8_SA(1, 1), a1 + hA, vA, sA);
            PG8_WAIT_V(8); PG8_WAIT_L(0); PG8_BAR; PG8_MMA(0, 0, At, B0); PG8_MMA(0, 1, At, B1); PG8_BAR; PG8_SCHED;
            PG8_LDA(At, 0, 1); PG8_STAGE(PG8_SB(0, 0), b2, vB2, sB2); PG8_STAGE(PG8_SB(0, 1), b2 + hB2, vB2, sB2); PG8_STAGE(PG8_SA(0, 0), a2, vA2, sA2);
            PG8_WAIT_V(8); PG8_WAIT_L(0); PG8_BAR; PG8_MMA(1, 0, At, B0); PG8_MMA(1, 1, At, B1); PG8_BAR; PG8_SCHED;
            PG8_LDB(B0, 1, 0); PG8_LDB(B1, 1, 1); PG8_SCHED; PG8_LDA(At, 1, 0); PG8_STAGE(PG8_SA(0, 1), a2 + hA2, vA2, sA2);
            PG8_WAIT_V(8); PG8_WAIT_L(0); PG8_BAR; PG8_MMA(0, 0, At, B0); PG8_MMA(0, 1, At, B1); PG8_BAR; PG8_SCHED;
            PG8_LDA(At, 1, 1); PG8_STAGE(PG8_SB(1, 0), b3, vB2, sB2); PG8_STAGE(PG8_SB(1, 1), b3 + hB2, vB2, sB2); PG8_STAGE(PG8_SA(1, 0), a3, vA2, sA2);
            PG8_WAIT_V(8); PG8_WAIT_L(0); PG8_BAR; PG8_MMA(1, 0, At, B0); PG8_MMA(1, 1, At, B1); PG8_BAR; PG8_SCHED;
        }
        if constexpr (ALIGN) { if (wr == 0) PG8_BAR; }
        const bool chain = (cur.tag & 0x100) != 0;
        if (!chain) { int t2 = my_tid(); asm volatile("" : "+v"(t2)); E(acc, cur, wr, wc, t2 & 15, (t2 >> 4) & 3); }
        if (!has_next) break;
        if (!chain)
#pragma unroll
        for (int a = 0; a < 2; ++a)
#pragma unroll
            for (int b = 0; b < 2; ++b)
#pragma unroll
                for (int m = 0; m < 4; ++m)
#pragma unroll
                    for (int n = 0; n < 2; ++n) acc[a][b][m][n] = (f32x4){0.f, 0.f, 0.f, 0.f};
        cur = nxt; cA = nA; cB = nB; vA = nvA; vB = nvB; sA = nsA; sB = nsB; ++ui;
        if constexpr (ALIGN) { if (wr == 1) PG8_BAR; }
    }
    PG8_WAIT_V(0);
    if constexpr (!ALIGN) { if (wr == 0) PG8_BAR; }
    PG8_BAR;
#undef PG8_SA
#undef PG8_SB
#undef PG8_STAGE
#undef PG8_LDA
#undef PG8_LDB
#undef PG8_MMA
#undef PG8_WAIT_V
#undef PG8_WAIT_L
#undef PG8_BAR
#undef PG8_SCHED
}
}
using eng::Unit;
typedef f32x4 AccT[2][2][4][2];

#define EPI_LOOP_BEGIN \
    _Pragma("unroll") for (int ai = 0; ai < 2; ++ai) _Pragma("unroll") for (int m = 0; m < 4; ++m) { const int row = u.pm * 256 + ai * 128 + wr * 64 + m * 16 + fr; \
    _Pragma("unroll") for (int bj = 0; bj < 2; ++bj) { const int col0 = u.pn * 256 + bj * 128 + wc * 32 + 8 * fq; f32x4 v0 = acc[ai][bj][m][0], v1 = acc[ai][bj][m][1];
#define EPI_LOOP_END } }

DI u32x4 pack8(const f32x4& v0, const f32x4& v1) { u32x4 w; w.x = pk2(v0[0], v0[1]); w.y = pk2(v0[2], v0[3]); w.z = pk2(v1[0], v1[1]); w.w = pk2(v1[2], v1[3]); return w; }
DI void rope8(f32x4& v0, f32x4& v1, const float2* tab) {
    const float2 c0 = tab[0], c1 = tab[1], c2 = tab[2], c3 = tab[3];
    float a, b;
    a = v0[0]; b = v0[1]; v0[0] = a * c0.x - b * c0.y; v0[1] = b * c0.x + a * c0.y;
    a = v0[2]; b = v0[3]; v0[2] = a * c1.x - b * c1.y; v0[3] = b * c1.x + a * c1.y;
    a = v1[0]; b = v1[1]; v1[0] = a * c2.x - b * c2.y; v1[1] = b * c2.x + a * c2.y;
    a = v1[2]; b = v1[3]; v1[2] = a * c3.x - b * c3.y; v1[3] = b * c3.x + a * c3.y;
}

struct EpiInProj {
    bf16_t* P; const float2* ropeH; const float2* ropeR; float* ssq_q; float* ssq_kv;
    DI void operator()(const AccT& acc, const Unit& u, int wr, int wc, int fr, int fq) const {
        asm volatile("" : "+v"(fr), "+v"(fq));
        EPI_LOOP_BEGIN
            const int pos = row & (SEQ - 1);
            const bool r64 = (col0 < C_SV) || (col0 >= C_RQ && col0 < C_RV);
            const bool r32 = (col0 >= C_KR && col0 < C_KR + 32);
            if (r64) rope8(v0, v1, ropeH + pos * 32 + ((col0 & 63) >> 1));
            if (r32) rope8(v0, v1, ropeR + pos * 16 + ((col0 - C_KR) >> 1));
            float sc = 1.f;
            if (col0 < C_SK) sc = 0.125f * LOG2E;
            if (col0 >= C_RK && col0 < C_RV) sc = 0.125f;
            v0 = v0 * sc; v1 = v1 * sc;
            if (col0 >= C_CQ && col0 < C_KR) {
                float s = (v0[0] * v0[0] + v0[1] * v0[1]) + (v0[2] * v0[2] + v0[3] * v0[3]) + (v1[0] * v1[0] + v1[1] * v1[1]) + (v1[2] * v1[2] + v1[3] * v1[3]);
                s += __shfl_xor(s, 16); s += __shfl_xor(s, 32);
                if (fq == 0) { if (col0 < C_CKV) ssq_q[row * 8 + bj * 4 + wc] = s; else ssq_kv[row * 4 + wc] = s; }
            }
            if (col0 >= C_U && col0 < C_RQ) { const int ch = col0 - C_U; const int R = (ch >> 4) * 1024 + (row >> 5);
                *(u32x4*)(P + (size_t)R * PP + C_U + (row & 31) * 16 + (ch & 15)) = pack8(v0, v1); }
            else *(u32x4*)(P + (size_t)row * PP + col0) = pack8(v0, v1);
        EPI_LOOP_END
    }
};
struct EpiLE {
    bf16_t* LEb;
    DI void operator()(const AccT& acc, const Unit& u, int wr, int wc, int fr, int fq) const {
        asm volatile("" : "+v"(fr), "+v"(fq));
        EPI_LOOP_BEGIN
            if (bj == 0) *(u32x4*)(LEb + (size_t)row * 128 + (col0 & 127)) = pack8(v0, v1);
        EPI_LOOP_END
    }
};
DI float gelu_tanh(float y) { const float t = 0.7978845608028654f * (y + 0.044715f * y * y * y); const float e = ex2(2.f * LOG2E * t); const float th = 1.f - 2.f * __builtin_amdgcn_rcpf(e + 1.f); return 0.5f * y * (1.f + th); }
struct EpiS5Out {
    bf16_t* P; const float* dskip;
    DI void operator()(const AccT& acc, const Unit& u, int wr, int wc, int fr, int fq) const {
        asm volatile("" : "+v"(fr), "+v"(fq));
        EPI_LOOP_BEGIN
            const int g = row >> 10, cr = row & 1023, t = (col0 & 511) >> 4, c0 = col0 & 15;
            const size_t token = (size_t)(cr >> 7) * SEQ + (size_t)(cr & 127) * 32 + t;
            const u32x4 uv = *(const u32x4*)(P + (size_t)row * PP + C_U + t * 16 + c0);
            const f32x4 d0 = *(const f32x4*)(dskip + 16 * g + c0), d1 = *(const f32x4*)(dskip + 16 * g + c0 + 4);
            v0[0] = gelu_tanh(v0[0] + d0[0] * bflo(uv.x)); v0[1] = gelu_tanh(v0[1] + d0[1] * bfhi(uv.x)); v0[2] = gelu_tanh(v0[2] + d0[2] * bflo(uv.y)); v0[3] = gelu_tanh(v0[3] + d0[3] * bfhi(uv.y));
            v1[0] = gelu_tanh(v1[0] + d1[0] * bflo(uv.z)); v1[1] = gelu_tanh(v1[1] + d1[1] * bfhi(uv.z)); v1[2] = gelu_tanh(v1[2] + d1[2] * bflo(uv.w)); v1[3] = gelu_tanh(v1[3] + d1[3] * bfhi(uv.w));
            const int ch = 16 * g + c0;
            *(u32x4*)(P + token * PP + (ch < 256 ? C_SK + ch : C_CQ + ch - 256)) = pack8(v0, v1);
        EPI_LOOP_END
    }
};
struct EpiQup {
    bf16_t* Qm; const float2* ropeR; const float* ssq_q;
    DI void operator()(const AccT& acc, const Unit& u, int wr, int wc, int fr, int fq) const {
        asm volatile("" : "+v"(fr), "+v"(fq));
        EPI_LOOP_BEGIN
            const f32x4 q0 = *(const f32x4*)(ssq_q + row * 8), q1 = *(const f32x4*)(ssq_q + row * 8 + 4);
            const float sc = rsqrtf((((q0[0] + q0[1]) + (q0[2] + q0[3])) + ((q1[0] + q1[1]) + (q1[2] + q1[3]))) * (1.f / 256.f) + EPS) * (0.10206207261596577f * LOG2E);
            v0 = v0 * sc; v1 = v1 * sc;
            if (col0 >= 512) rope8(v0, v1, ropeR + (row & (SEQ - 1)) * 16 + ((col0 & 31) >> 1));
            *(u32x4*)(Qm + (size_t)row * 768 + col0) = pack8(v0, v1);
        EPI_LOOP_END
    }
};
struct EpiKVup {
    bf16_t* KV; const float* ssq_kv;
    DI void operator()(const AccT& acc, const Unit& u, int wr, int wc, int fr, int fq) const {
        asm volatile("" : "+v"(fr), "+v"(fq));
        EPI_LOOP_BEGIN
            const f32x4 q0 = *(const f32x4*)(ssq_kv + row * 4);
            const float sc = rsqrtf(((q0[0] + q0[1]) + (q0[2] + q0[3])) * (1.f / 128.f) + EPS);
            v0 = v0 * sc; v1 = v1 * sc;
            *(u32x4*)(KV + (size_t)row * 1024 + col0) = pack8(v0, v1);
        EPI_LOOP_END
    }
};
struct EpiGlu {
    bf16_t* P;
    DI void operator()(const AccT& acc, const Unit& u, int wr, int wc, int fr, int fq) const {
        asm volatile("" : "+v"(fr), "+v"(fq));
        EPI_LOOP_BEGIN
            u32x2 w; w.x = pk2(v0[0] * sigmoidf_(v0[1]), v0[2] * sigmoidf_(v0[3])); w.y = pk2(v1[0] * sigmoidf_(v1[1]), v1[2] * sigmoidf_(v1[3]));
            *(u32x2*)(P + (size_t)row * PP + C_RQ + (col0 >> 1)) = w;
        EPI_LOOP_END
    }
};
struct EpiMerge {
    bf16_t* merged; u32x4* scrB; u32x4* scrM;
    DI void operator()(const AccT& acc, const Unit& u, int wr, int wc, int fr, int fq) const {
        asm volatile("" : "+v"(fr), "+v"(fq));
        int tid = my_tid(); asm volatile("" : "+v"(tid)); const int b = u.tag >> 1; u32x4* sB = scrB + tid; u32x4* sM = scrM + tid;
        if ((u.tag & 1) == 0) {
            EPI_LOOP_BEGIN
                *sB = pack8(v0, v1); sB += 512; asm volatile("" : "+v"(sB)); (void)row; (void)col0;
            EPI_LOOP_END
        } else {
#pragma unroll
            for (int ai = 0; ai < 2; ++ai) {
                asm volatile("" : "+v"(sB), "+v"(sM));
                u32x4 gp[8], bpv[8], mpv[8];
#pragma unroll
                for (int q = 0; q < 8; ++q) { const int m = q >> 1, bj = q & 1; const f32x4 v0 = acc[ai][bj][m][0], v1 = acc[ai][bj][m][1]; f32x4 g0, g1;
#pragma unroll
                    for (int e = 0; e < 4; ++e) { g0[e] = sigmoidf_(v0[e]); g1[e] = sigmoidf_(v1[e]); }
                    gp[q] = pack8(g0, g1); }
#pragma unroll
                for (int q = 0; q < 8; ++q) { bpv[q] = sB[q * 512]; if (b > 0) mpv[q] = sM[q * 512]; }
#pragma unroll
                for (int q = 0; q < 8; ++q) { const int m = q >> 1, bj = q & 1;
                    const int row = u.pm * 256 + ai * 128 + wr * 64 + m * 16 + fr, col0 = u.pn * 256 + bj * 128 + wc * 32 + 8 * fq;
                    const u32x4 g = gp[q], bp = bpv[q]; f32x4 p0, p1;
                    p0[0] = bflo(g.x) * bflo(bp.x); p0[1] = bfhi(g.x) * bfhi(bp.x); p0[2] = bflo(g.y) * bflo(bp.y); p0[3] = bfhi(g.y) * bfhi(bp.y);
                    p1[0] = bflo(g.z) * bflo(bp.z); p1[1] = bfhi(g.z) * bfhi(bp.z); p1[2] = bflo(g.w) * bflo(bp.w); p1[3] = bfhi(g.w) * bfhi(bp.w);
                    if (b > 0) { const u32x4 mp = mpv[q];
                        p0[0] += bflo(mp.x); p0[1] += bfhi(mp.x); p0[2] += bflo(mp.y); p0[3] += bfhi(mp.y); p1[0] += bflo(mp.z); p1[1] += bfhi(mp.z); p1[2] += bflo(mp.w); p1[3] += bfhi(mp.w); }
                    const u32x4 o = pack8(p0, p1);
                    if (b < 3) sM[q * 512] = o; else *(u32x4*)(merged + (size_t)row * 1024 + col0) = o; }
                sB += 4096; sM += 4096;
            }
        }
    }
};
struct EpiZ {
    bf16_t* Z; float* ssq;
    DI void operator()(const AccT& acc, const Unit& u, int wr, int wc, int fr, int fq) const {
        asm volatile("" : "+v"(fr), "+v"(fq));
#pragma unroll
        for (int ai = 0; ai < 2; ++ai)
#pragma unroll
            for (int m = 0; m < 4; ++m) { const int row = u.pm * 256 + ai * 128 + wr * 64 + m * 16 + fr; float s = 0.f;
#pragma unroll
                for (int bj = 0; bj < 2; ++bj) { const int col0 = u.pn * 256 + bj * 128 + wc * 32 + 8 * fq; const f32x4 v0 = acc[ai][bj][m][0], v1 = acc[ai][bj][m][1];
                    s += (v0[0] * v0[0] + v0[1] * v0[1]) + (v0[2] * v0[2] + v0[3] * v0[3]) + (v1[0] * v1[0] + v1[1] * v1[1]) + (v1[2] * v1[2] + v1[3] * v1[3]);
                    *(u32x4*)(Z + (size_t)row * 1024 + col0) = pack8(v0, v1); }
                s += __shfl_xor(s, 16); s += __shfl_xor(s, 32);
                if (fq == 0) ssq[row * 16 + u.pn * 4 + wc] = s; }
    }
};
struct EpiFF1 {
    bf16_t* H;
    DI void operator()(const AccT& acc, const Unit& u, int wr, int wc, int fr, int fq) const {
        asm volatile("" : "+v"(fr), "+v"(fq));
        EPI_LOOP_BEGIN
#pragma unroll
            for (int e = 0; e < 4; ++e) { float a = fmaxf(v0[e], 0.f); v0[e] = a * a; float c = fmaxf(v1[e], 0.f); v1[e] = c * c; }
            *(u32x4*)(H + ((((size_t)u.pm * 64 + (col0 >> 6)) * 256 + (row & 255)) * 64 + (col0 & 63))) = pack8(v0, v1);
        EPI_LOOP_END
    }
};

struct S5StateSched {
    const char* P; const char* Wst; int G, c;
    DI bool next(int i, Unit& u) const { const int t = (G - 1 - c) + i * G; if (t >= 128) return false;
        u.pm = t; u.pn = 0; u.tag = 0; u.ksA = 128; u.A = P + ((size_t)t * 256 * PP + C_U) * 2; u.ldaB = PP * 2; u.B = Wst + (size_t)(t >> 2) * 128 * 512 * 2; u.kB = 1024; u.nt = 8; return true; }
};
struct S5OutSched {
    const char* P; const char* Xp; const char* Tz; const char* Mc; int G, c;
    DI bool next(int i, Unit& u) const { const int t = c + (i >> 1) * G; if (t >= 256) return false; const int gp = t >> 1, pn = t & 1, g = t >> 3;
        u.pm = gp; u.pn = pn; u.ksA = 128;
        if ((i & 1) == 0) { u.tag = 0x100; u.A = P + ((size_t)gp * 256 * PP + C_U) * 2; u.ldaB = PP * 2; u.B = Tz + (size_t)(g * 512 + pn * 256) * 512 * 2; u.kB = 1024; u.nt = 8; }
        else { u.tag = 0; u.A = Xp + (size_t)gp * 256 * 128 * 2; u.ldaB = 256; u.B = Mc + (size_t)(g * 512 + pn * 256) * 128 * 2; u.kB = 256; u.nt = 2; }
        return true; }
};
struct GluSched {
    const char* P; const char* W; int G, c;
    DI bool next(int i, Unit& u) const { int pm, pn; if (!eng::tile_of(i >> 1, G, c, 128, 4, pm, pn)) return false; const int sub = i & 1;
        u.pm = pm; u.pn = pn; u.ksA = 128; u.tag = sub ? 0 : 0x100; u.A = P + ((size_t)pm * 256 * PP + (sub ? C_CQ : C_SK)) * 2; u.ldaB = PP * 2;
        u.B = W + ((size_t)pn * 256 * 512 + sub * 256) * 2; u.kB = 1024; u.nt = 4; return true; }
};
struct MergeSched {
    const char* XN; const char* Wg; const char* Wb; const char* P; const char* Qm; int G, c;
    DI bool next(int i, Unit& u) const {
        const int ti = i >> 3, sub = i & 7, b = sub >> 1; int pm, pn;
        if (!eng::tile_of(ti, G, c, 128, 4, pm, pn)) return false;
        u.pm = pm; u.pn = pn; u.tag = sub; u.ksA = 128;
        if (sub & 1) { u.A = XN + (size_t)pm * 256 * 2048; u.ldaB = 2048; u.kB = 2048; u.nt = 16; u.B = Wg + (size_t)(b * 1024 + pn * 256) * 2048; }
        else { const int ld = (b == 3) ? 768 * 2 : PP * 2; const int coff = (b == 0) ? C_SQ * 2 : (b == 1) ? C_RQ * 2 : (b == 2) ? C_RG * 2 : 0;
            const char* Y = (b == 3) ? Qm : P;
            u.A = Y + coff + (size_t)pm * 256 * ld; u.ldaB = ld; u.kB = 1024; u.nt = 8; u.B = Wb + (size_t)(b * 1024 + pn * 256) * 1024; }
        return true;
    }
};

enum { MAP_IN = 0, MAP_GATE, MAP_GLU, MAP_UQ, MAP_UKV, MAP_ID };
DI int il(int w, int dim) { return (w >> 1) + (dim >> 1) * (w & 1); }
DI int srccol(int kind, int j) {
    switch (kind) {
    case MAP_IN:
        if (j < C_SV) return (j & ~63) + il(j & 63, 64);
        if (j < C_RQ) return j;
        if (j < C_RV) return (j & ~63) + il(j & 63, 64);
        if (j < C_KR) return j;
        if (j < C_KR + 32) return C_KR + il(j - C_KR, 32);
        return -1;
    case MAP_GATE: return 3232 + j;
    case MAP_GLU: return (j >> 1) + 512 * (j & 1);
    case MAP_UQ: if (j < 512) return (j >> 6) * 96 + (j & 63); else { const int jj = j - 512; return (jj >> 5) * 96 + 64 + il(jj & 31, 32); }
    case MAP_UKV: if (j < 512) return (j >> 6) * 128 + (j & 63); else { const int jj = j - 512; return (jj >> 6) * 128 + 64 + (jj & 63); }
    default: return j;
    }
}
DI void conv_item(const float* W, int ldw, int K, int Ndst, int kind, const float* kscale, bf16_t* WT, LAS float* scr, int item, int lane, int ldo = 0) {
    if (ldo == 0) ldo = K;
    const int nblk = Ndst / 32, kb = item / nblk, nb = item % nblk, k0 = 64 * kb, n0 = 32 * nb;
    const int sc = srccol(kind, n0 + (lane & 31));
    float wv[32];
#pragma unroll
    for (int i = 0; i < 32; ++i) { const int kk = 2 * i + (lane >> 5); wv[i] = (sc >= 0) ? W[(size_t)(k0 + kk) * ldw + sc] : 0.f; }
#pragma unroll
    for (int i = 0; i < 32; ++i) { const int kk = 2 * i + (lane >> 5); float v = wv[i]; if (kscale) v *= kscale[k0 + kk]; scr[kk * 33 + (lane & 31)] = v; }
    asm volatile("s_waitcnt lgkmcnt(0)" ::: "memory");
    const int c = lane & 7;
#pragma unroll
    for (int j = 0; j < 4; ++j) { const int n = (lane >> 3) + 8 * j; const LAS float* s = scr + (8 * c) * 33 + n;
        u32x4 o; o.x = pk2(s[0 * 33], s[1 * 33]); o.y = pk2(s[2 * 33], s[3 * 33]); o.z = pk2(s[4 * 33], s[5 * 33]); o.w = pk2(s[6 * 33], s[7 * 33]);
        *(u32x4*)(WT + (size_t)(n0 + n) * ldo + k0 + 8 * c) = o; }
    asm volatile("s_waitcnt lgkmcnt(0)" ::: "memory");
}
DI void prep_weights(const Args& a, int l, LAS unsigned char* lds) {
    int tid = my_tid(); asm volatile("" : "+v"(tid)); const int lane = tid & 63, wave = tid >> 6;
    LAS float* scr = (LAS float*)(lds + wave * 8704);
    unsigned char* ws = a.ws;
    const float* w_in = a.in[5] + (size_t)l * DM * DIN;
    constexpr int I_IN = 16 * 104, I_GATE = 16 * 128, I_GLU = 8 * 32, I_UQ = 4 * 24, I_UKV = 2 * 32, I_BR = 8 * 32, I_OUT = 16 * 32, I_FF1 = 16 * 128, I_FF2 = 64 * 32;
    constexpr int NIT = I_IN + I_GATE + I_GLU + I_UQ + I_UKV + 4 * I_BR + I_OUT + I_FF1 + I_FF2;
    const int gw = blockIdx.x * 8 + wave, NGW = gridDim.x * 8;
    for (int it = gw; it < NIT; it += NGW) {
        int r = it;
        if (r < I_IN) { conv_item(w_in, DIN, 1024, 3328, MAP_IN, nullptr, (bf16_t*)(ws + W_IN), scr, r, lane); continue; } r -= I_IN;
        if (r < I_GATE) { conv_item(w_in, DIN, 1024, 4096, MAP_GATE, nullptr, (bf16_t*)(ws + W_GATE), scr, r, lane); continue; } r -= I_GATE;
        if (r < I_GLU) { conv_item(a.in[15] + (size_t)l * 512 * 1024, 1024, 512, 1024, MAP_GLU, nullptr, (bf16_t*)(ws + W_GLU), scr, r, lane); continue; } r -= I_GLU;
        if (r < I_UQ) { conv_item(a.in[18] + (size_t)l * 256 * 768, 768, 256, 768, MAP_UQ, a.in[16] + l * 256, (bf16_t*)(ws + W_UQ), scr, r, lane); continue; } r -= I_UQ;
        if (r < I_UKV) { conv_item(a.in[19] + (size_t)l * 128 * 1024, 1024, 128, 1024, MAP_UKV, a.in[17] + l * 128, (bf16_t*)(ws + W_UKV), scr, r, lane); continue; } r -= I_UKV;
        if (r < 4 * I_BR) { const int b = r / I_BR; conv_item(a.in[20] + ((size_t)l * 4 + b) * 512 * 1024, 1024, 512, 1024, MAP_ID, nullptr, (bf16_t*)(ws + W_BR) + (size_t)b * 1024 * 512, scr, r % I_BR, lane); continue; } r -= 4 * I_BR;
        if (r < I_OUT) { conv_item(a.in[21] + (size_t)l * 1024 * 1024, 1024, 1024, 1024, MAP_ID, nullptr, (bf16_t*)(ws + W_OUT), scr, r, lane); continue; } r -= I_OUT;
        if (r < I_FF1) { conv_item(a.in[22] + (size_t)l * 1024 * 4096, 4096, 1024, 4096, MAP_ID, nullptr, (bf16_t*)(ws + W_FF1), scr, r, lane); continue; } r -= I_FF1;
        conv_item(a.in[23] + (size_t)l * 4096 * 1024, 1024, 4096, 1024, MAP_ID, nullptr, (bf16_t*)(ws + W_FF2), scr, r, lane, HP);
    }
}

DI void s5_tables(const Args& a, int l, LAS unsigned char* lds) {
    LAS float* are = (LAS float*)lds;
    LAS float* aim = are + 33 * 64;
    LAS float* bbr = aim + 33 * 64;
    LAS float* bbi = bbr + 1024;
    LAS float* cre = bbi + 1024;
    LAS float* cim = cre + 1024;
    LAS float* ktab = cim + 1024;
    int tid = my_tid(); asm volatile("" : "+v"(tid));
    unsigned char* ws = a.ws;
    for (int un = blockIdx.x; un < 256; un += gridDim.x) {
        const int g = un >> 3, j4 = (un & 7) * 4;
        __syncthreads();
        const float* lam_re = a.in[7] + ((size_t)l * 32 + g) * 64; const float* lam_im = a.in[8] + ((size_t)l * 32 + g) * 64;
        const float dt = expf(a.in[9][l * 32 + g]);
        const float* b_re = a.in[10] + ((size_t)l * 32 + g) * 1024; const float* b_im = a.in[11] + ((size_t)l * 32 + g) * 1024;
        const float* c_re = a.in[12] + ((size_t)l * 32 + g) * 1024; const float* c_im = a.in[13] + ((size_t)l * 32 + g) * 1024;
        for (int e = tid; e < 33 * 64; e += 512) { const int tau = e >> 6, p = e & 63; const float mag = expf(lam_re[p] * dt * (float)tau); float sn, cs; sincosf(lam_im[p] * dt * (float)tau, &sn, &cs); are[e] = mag * cs; aim[e] = mag * sn; }
        for (int e = tid; e < 1024; e += 512) { const int p = e >> 4; const float lr = lam_re[p], li = lam_im[p]; const float mag = expf(lr * dt); float sn, cs; sincosf(li * dt, &sn, &cs);
            const float nr = mag * cs - 1.f, ni = mag * sn, den = lr * lr + li * li; const float fr_ = (nr * lr + ni * li) / den, fi_ = (ni * lr - nr * li) / den;
            const float br = b_re[e], bi = b_im[e]; bbr[e] = fr_ * br - fi_ * bi; bbi[e] = fr_ * bi + fi_ * br;
            cre[e] = c_re[e]; cim[e] = c_im[e]; }
        __syncthreads();
        for (int e = tid; e < 4 * 256; e += 512) { const int tau = j4 + (e >> 8), c = (e >> 4) & 15, c2 = e & 15; float s = 0.f;
            for (int p = 0; p < 64; ++p) { const float cr = cre[c * 64 + p], ci = cim[c * 64 + p], ar = are[tau * 64 + p], ai = aim[tau * 64 + p];
                const float car = cr * ar - ci * ai, cai = cr * ai + ci * ar; s += car * bbr[p * 16 + c2] - cai * bbi[p * 16 + c2]; }
            ktab[e] = s; }
        __syncthreads();
        bf16_t* Tz = (bf16_t*)(ws + OFF_TZ) + (size_t)g * 512 * 512;
        for (int e = tid; e < 4 * 32 * 32; e += 512) { const int tq = e >> 10, t = (e >> 5) & 31, c = (e >> 1) & 15, hf = e & 1; const int tau = j4 + tq, sx = t - tau;
            if (sx >= 0) { const LAS float* kp = ktab + tq * 256 + c * 16 + hf * 8; u32x4 o; o.x = pk2(kp[0], kp[1]); o.y = pk2(kp[2], kp[3]); o.z = pk2(kp[4], kp[5]); o.w = pk2(kp[6], kp[7]);
                *(u32x4*)(Tz + (size_t)(t * 16 + c) * 512 + sx * 16 + hf * 8) = o; } }
        for (int e = tid; e < 4 * 16 * 64; e += 512) { const int t = j4 + (e >> 10), c = (e >> 6) & 15, k0 = (e & 63) * 8;
            if ((k0 >> 4) > t) *(u32x4*)(Tz + (size_t)(t * 16 + c) * 512 + k0) = (u32x4){0u, 0u, 0u, 0u}; }
        bf16_t* Mc = (bf16_t*)(ws + OFF_MC) + (size_t)g * 512 * 128;
        for (int e = tid; e < 64 * 128; e += 512) { const int n = j4 * 16 + (e >> 7), pp = e & 127, p = pp & 63, t = n >> 4, c = n & 15;
            const float cr = cre[c * 64 + p], ci = cim[c * 64 + p], ar = are[(t + 1) * 64 + p], ai = aim[(t + 1) * 64 + p];
            const float v = (pp < 64) ? (cr * ar - ci * ai) : -(cr * ai + ci * ar); Mc[(size_t)n * 128 + pp] = (bf16_t)f2bf(v); }
        bf16_t* Wst = (bf16_t*)(ws + OFF_WST) + (size_t)g * 128 * 512;
        for (int e = tid; e < 128 * 64; e += 512) { const int pp = e >> 6, k = j4 * 16 + (e & 63), p = pp & 63, sx = k >> 4, c2 = k & 15;
            const float ar = are[(31 - sx) * 64 + p], ai = aim[(31 - sx) * 64 + p], br = bbr[p * 16 + c2], bi = bbi[p * 16 + c2];
            const float v = (pp < 64) ? (ar * br - ai * bi) : (ar * bi + ai * br); Wst[(size_t)pp * 512 + k] = (bf16_t)f2bf(v); }
        float* aT = (float*)(ws + OFF_AT) + g * 128;
        if (j4 == 0 && tid < 128) aT[tid] = (tid < 64) ? are[32 * 64 + tid] : aim[32 * 64 + tid - 64];
    }
}

DI void norm_rows_first(const float* x, const float* g, bf16_t* XN) {
    int tid = my_tid(); asm volatile("" : "+v"(tid)); const int lane = tid & 63; const int gw = blockIdx.x * 8 + (tid >> 6), NGW = gridDim.x * 8;
    for (int m0 = 2 * gw; m0 < M; m0 += 2 * NGW) {
        f32x4 v[2][4];
#pragma unroll
        for (int q = 0; q < 2; ++q) { const f32x4* xr = (const f32x4*)(x + (size_t)(m0 + q) * DM) + lane;
#pragma unroll
            for (int j = 0; j < 4; ++j) v[q][j] = xr[64 * j]; }
#pragma unroll
        for (int q = 0; q < 2; ++q) { float s = 0.f;
#pragma unroll
            for (int j = 0; j < 4; ++j) s += (v[q][j].x * v[q][j].x + v[q][j].y * v[q][j].y) + (v[q][j].z * v[q][j].z + v[q][j].w * v[q][j].w);
            const float rstd = rsqrtf(wave_sum(s) * (1.f / DM) + EPS);
            u32x2* o = (u32x2*)(XN + (size_t)(m0 + q) * DM) + lane;
#pragma unroll
            for (int j = 0; j < 4; ++j) { const f32x4 gg = ((const f32x4*)g)[lane + 64 * j]; u32x2 w; w.x = pk2(v[q][j].x * rstd * gg.x, v[q][j].y * rstd * gg.y); w.y = pk2(v[q][j].z * rstd * gg.z, v[q][j].w * rstd * gg.w); o[64 * j] = w; } }
    }
}
template <bool XIN, bool XOUT>
DI void norm_rows_res(const void* xsrc, const bf16_t* Z, const float* ssq, const float* gpost, void* out, const float* gpre, bf16_t* XN) {
    int tid = my_tid(); asm volatile("" : "+v"(tid)); const int lane = tid & 63; const int gw = blockIdx.x * 8 + (tid >> 6), NGW = gridDim.x * 8;
    for (int m0 = 4 * gw; m0 < M; m0 += 4 * NGW) {
        f32x4 xv[4][4]; u32x2 zw[4][4]; float sq[4];
#pragma unroll
        for (int q = 0; q < 4; ++q) { const int m = m0 + q; const u32x2* zr = (const u32x2*)(Z + (size_t)m * DM) + lane;
            sq[q] = ssq[(size_t)m * 16 + (lane & 15)];
#pragma unroll
            for (int j = 0; j < 4; ++j) { zw[q][j] = zr[64 * j];
                if (XIN) { const u32x2 xw = ((const u32x2*)((const bf16_t*)xsrc + (size_t)m * DM) + lane)[64 * j]; xv[q][j] = (f32x4){bflo(xw.x), bfhi(xw.x), bflo(xw.y), bfhi(xw.y)}; }
                else xv[q][j] = ((const f32x4*)((const float*)xsrc + (size_t)m * DM) + lane)[64 * j]; } }
#pragma unroll
        for (int q = 0; q < 4; ++q) { const int m = m0 + q;
            float s2 = sq[q]; s2 += __shfl_xor(s2, 1); s2 += __shfl_xor(s2, 2); s2 += __shfl_xor(s2, 4); s2 += __shfl_xor(s2, 8);
            const float rz = rsqrtf(s2 * (1.f / DM) + EPS);
            f32x4 v[4]; float s = 0.f;
#pragma unroll
            for (int j = 0; j < 4; ++j) { const f32x4 gp = ((const f32x4*)gpost)[lane + 64 * j]; const f32x4 x4 = xv[q][j]; const u32x2 z2 = zw[q][j];
                v[j].x = x4.x + bflo(z2.x) * rz * gp.x; v[j].y = x4.y + bfhi(z2.x) * rz * gp.y; v[j].z = x4.z + bflo(z2.y) * rz * gp.z; v[j].w = x4.w + bfhi(z2.y) * rz * gp.w;
                s += (v[j].x * v[j].x + v[j].y * v[j].y) + (v[j].z * v[j].z + v[j].w * v[j].w); }
#pragma unroll
            for (int j = 0; j < 4; ++j) {
                if (XOUT) { u32x2 w; w.x = pk2(v[j].x, v[j].y); w.y = pk2(v[j].z, v[j].w); ((u32x2*)((bf16_t*)out + (size_t)m * DM) + lane)[64 * j] = w; }
                else ((f32x4*)((float*)out + (size_t)m * DM) + lane)[64 * j] = v[j]; }
            if (gpre) { const float rstd = rsqrtf(wave_sum(s) * (1.f / DM) + EPS); u32x2* o = (u32x2*)(XN + (size_t)m * DM) + lane;
#pragma unroll
                for (int j = 0; j < 4; ++j) { const f32x4 gg = ((const f32x4*)gpre)[lane + 64 * j]; u32x2 w; w.x = pk2(v[j].x * rstd * gg.x, v[j].y * rstd * gg.y); w.y = pk2(v[j].z * rstd * gg.z, v[j].w * rstd * gg.w); o[64 * j] = w; } }
        }
    }
}

template <int MODE>
DI void attn_unit(LAS unsigned char* lds, int b, int hd, int qb, bf16_t* P, bf16_t* Qm, const bf16_t* KV, float sink_l2) {
    constexpr int NS = MODE == 0 ? 6 : 4, NC = MODE == 0 ? 12 : 8, KSTR = MODE == 0 ? 208 : 144, VSTR = 272, NKC = MODE == 0 ? 3 : 2, BUFB = 45056;
    int tid = my_tid(); asm volatile("" : "+v"(tid)); const int lane = tid & 63, r = lane & 31, h = lane >> 5, wid = __builtin_amdgcn_readfirstlane(tid >> 6);
    LAS unsigned char* Ks0 = lds; LAS unsigned char* Vt0 = lds + 128 * 208; LAS float* wsf = (LAS float*)(lds + 2 * BUFB) + wid * 32;
    const int q0 = qb * 256; const size_t rowbase = (size_t)b * SEQ; const int kvh = hd >> 2;
    const size_t qrow = rowbase + q0 + wid * 32 + r;
    bf16x8 qf[NS];
#pragma unroll
    for (int s = 0; s < NS; ++s) {
        if (MODE == 0) qf[s] = (s < 4) ? *(const bf16x8*)(Qm + qrow * 768 + hd * 64 + 16 * s + 8 * h) : *(const bf16x8*)(Qm + qrow * 768 + 512 + hd * 32 + 16 * (s - 4) + 8 * h);
        else qf[s] = *(const bf16x8*)(P + qrow * PP + C_SQ + hd * 64 + 16 * s + 8 * h);
    }
    const int kt0 = (MODE == 1 && q0 >= 128) ? (q0 - 128) / 64 : 0, kt1 = (q0 + 255) / 64;
    float mrun = (MODE == 0) ? -1e30f : sink_l2, lrun = (MODE == 1 && h == 0) ? 1.f : 0.f;
    f32x16 O[2];
#pragma unroll
    for (int i = 0; i < 16; ++i) { O[0][i] = 0.f; O[1][i] = 0.f; }
    u32x4 kr[NKC], vr[2];
    auto ksrc = [&](int ci, int kp) -> const bf16_t* { const int row = ci / NC, c = ci % NC; const size_t gr = rowbase + (size_t)kp * 64 + row;
        if (MODE == 0) return (c < 8) ? KV + gr * 1024 + hd * 64 + 8 * c : P + gr * PP + C_KR + 8 * (c - 8);
        else return P + gr * PP + C_SK + kvh * 64 + 8 * c; };
    auto vsrc = [&](int ci, int kp) -> const bf16_t* { const int vrow = ci & 127, vc = ci >> 7; const size_t gr = rowbase + (size_t)kp * 64 + vrow;
        if (MODE == 0) return KV + gr * 1024 + 512 + hd * 64 + 8 * vc; else return P + gr * PP + C_SV + kvh * 64 + 8 * vc; };
#pragma unroll
    for (int j = 0; j < NKC; ++j) kr[j] = *(const u32x4*)ksrc(tid + 512 * j, kt0);
#pragma unroll
    for (int j = 0; j < 2; ++j) vr[j] = *(const u32x4*)vsrc(tid + 512 * j, kt0);
    const int wq_lo = q0 + wid * 32, wq_hi = wq_lo + 31;
    __syncthreads();
    for (int kp = kt0; kp <= kt1; kp += 2) {
        LAS unsigned char* Ks = Ks0 + (((kp - kt0) >> 1) & 1) * BUFB; LAS unsigned char* Vt = Vt0 + (((kp - kt0) >> 1) & 1) * BUFB;
#pragma unroll
        for (int j = 0; j < NKC; ++j) { const int ci = tid + 512 * j; *(LAS u32x4*)(Ks + (ci / NC) * KSTR + (ci % NC) * 16) = kr[j]; }
#pragma unroll
        for (int j = 0; j < 2; ++j) { const int ci = tid + 512 * j, vrow = ci & 127, vc = ci >> 7; const u32x4 v = vr[j]; LAS unsigned char* vb = Vt + (8 * vc) * VSTR + vpos(vrow) * 2;
          *(LAS bf16_t*)(vb + 0 * VSTR) = (bf16_t)(v.x & 0xffff); *(LAS bf16_t*)(vb + 1 * VSTR) = (bf16_t)(v.x >> 16);
          *(LAS bf16_t*)(vb + 2 * VSTR) = (bf16_t)(v.y & 0xffff); *(LAS bf16_t*)(vb + 3 * VSTR) = (bf16_t)(v.y >> 16);
          *(LAS bf16_t*)(vb + 4 * VSTR) = (bf16_t)(v.z & 0xffff); *(LAS bf16_t*)(vb + 5 * VSTR) = (bf16_t)(v.z >> 16);
          *(LAS bf16_t*)(vb + 6 * VSTR) = (bf16_t)(v.w & 0xffff); *(LAS bf16_t*)(vb + 7 * VSTR) = (bf16_t)(v.w >> 16); }
        __syncthreads();
        if (kp + 2 <= kt1) {
#pragma unroll
            for (int j = 0; j < NKC; ++j) kr[j] = *(const u32x4*)ksrc(tid + 512 * j, kp + 2);
#pragma unroll
            for (int j = 0; j < 2; ++j) vr[j] = *(const u32x4*)vsrc(tid + 512 * j, kp + 2);
        }
        {
        const int kv_lo = kp * 64;
        const bool skip = (kv_lo > wq_hi) || (MODE == 1 && kv_lo + 127 < wq_lo - 127);
        if (!skip) {
            f32x16 p[4];
#pragma unroll
            for (int t = 0; t < 4; ++t)
#pragma unroll
                for (int i = 0; i < 16; ++i) p[t][i] = 0.f;
#pragma unroll
            for (int s = 0; s < NS; ++s)
#pragma unroll
                for (int t = 0; t < 4; ++t) { const bf16x8 a0 = *(const LAS bf16x8*)(Ks + (32 * t + r) * KSTR + (16 * s + 8 * h) * 2); p[t] = MFMA32(a0, qf[s], p[t]); }
            const int qa = wq_lo + r;
            const bool need_mask = (MODE == 0) ? (kv_lo + 127 > wq_lo) : ((kv_lo + 127 > wq_lo) || (wq_hi - kv_lo >= 128));
            if (need_mask) {
#pragma unroll
                for (int t = 0; t < 4; ++t)
#pragma unroll
                    for (int i = 0; i < 16; ++i) { const int d0 = qa - (kv_lo + 32 * t + crow(i, h)); const bool ok = (MODE == 0) ? (d0 >= 0) : (d0 >= 0 && d0 < 128); p[t][i] = ok ? p[t][i] : -1e30f; }
            }
            float tmax = fmaxf(fmaxf(p[0][0], p[1][0]), fmaxf(p[2][0], p[3][0]));
#pragma unroll
            for (int i = 1; i < 16; ++i) tmax = fmaxf(fmaxf(fmaxf(tmax, p[0][i]), fmaxf(p[1][i], p[2][i])), p[3][i]);
            tmax = fmaxf(tmax, __shfl_xor(tmax, 32));
            const float mn = fmaxf(mrun, tmax), alpha = ex2(mrun - mn); mrun = mn;
            float ls = 0.f;
#pragma unroll
            for (int t = 0; t < 4; ++t)
#pragma unroll
                for (int i = 0; i < 16; ++i) { p[t][i] = ex2(p[t][i] - mn); ls += p[t][i]; }
            lrun = lrun * alpha + ls;
            if (__builtin_amdgcn_ballot_w64(alpha < 1.f) != 0ull) {
                if (h == 0) wsf[r] = alpha;
                __builtin_amdgcn_wave_barrier();
#pragma unroll
                for (int i = 0; i < 16; ++i) { const float af = wsf[crow(i, h)]; O[0][i] *= af; O[1][i] *= af; }
                __builtin_amdgcn_wave_barrier();
            }
#pragma unroll
            for (int s2 = 0; s2 < 8; ++s2) {
                const bf16x8 pa = packp(p[s2 >> 1], 8 * (s2 & 1));
#pragma unroll
                for (int dh = 0; dh < 2; ++dh) { const bf16x8 vb = *(const LAS bf16x8*)(Vt + (dh * 32 + r) * VSTR + (16 * s2 + 8 * h) * 2); O[dh] = MFMA32(pa, vb, O[dh]); }
            }
        }
        }
    }
    const float lt = lrun + __shfl_xor(lrun, 32);
    if (h == 0) wsf[r] = 1.f / lt;
    __builtin_amdgcn_wave_barrier();
#pragma unroll
    for (int i = 0; i < 16; ++i) { const float inv = wsf[crow(i, h)]; const size_t orow = rowbase + q0 + wid * 32 + crow(i, h);
#pragma unroll
        for (int dh = 0; dh < 2; ++dh) { const bf16_t o = (bf16_t)f2bf(O[dh][i] * inv);
            if (MODE == 0) Qm[orow * 768 + hd * 64 + dh * 32 + r] = o; else P[orow * PP + C_SQ + hd * 64 + dh * 32 + r] = o; } }
    __builtin_amdgcn_wave_barrier();
}

DI float ret_log2g(int hd) { return log2f(1.f - ex2(-5.f - (float)hd)); }
DI void ret_state_unit(LAS unsigned char* lds, const bf16_t* P, bf16_t* RS, int u) {
    const int b = u >> 7, n = (u >> 2) & 31, hd = u & 3;
    int tid = my_tid(); asm volatile("" : "+v"(tid)); const int lane = tid & 63, r = lane & 31, h = lane >> 5, wid = __builtin_amdgcn_readfirstlane(tid >> 6);
    LAS unsigned char* Kt = lds; LAS unsigned char* Vt = lds + 64 * 272;
    const size_t tok0 = (size_t)b * SEQ + n * 128; const float l2g = ret_log2g(hd);
    __syncthreads();
#pragma unroll
    for (int j = 0; j < 2; ++j) { const int ci = tid + 512 * j, row = ci & 127, c = ci >> 7; const u32x4 v = *(const u32x4*)(P + (tok0 + row) * PP + C_RK + hd * 64 + 8 * c);
        const float kw = ex2(l2g * (float)(127 - row)); LAS unsigned char* d = Kt + (8 * c) * 272 + row * 2;
        *(LAS bf16_t*)(d + 0 * 272) = (bf16_t)f2bf(bflo(v.x) * kw); *(LAS bf16_t*)(d + 1 * 272) = (bf16_t)f2bf(bfhi(v.x) * kw);
        *(LAS bf16_t*)(d + 2 * 272) = (bf16_t)f2bf(bflo(v.y) * kw); *(LAS bf16_t*)(d + 3 * 272) = (bf16_t)f2bf(bfhi(v.y) * kw);
        *(LAS bf16_t*)(d + 4 * 272) = (bf16_t)f2bf(bflo(v.z) * kw); *(LAS bf16_t*)(d + 5 * 272) = (bf16_t)f2bf(bfhi(v.z) * kw);
        *(LAS bf16_t*)(d + 6 * 272) = (bf16_t)f2bf(bflo(v.w) * kw); *(LAS bf16_t*)(d + 7 * 272) = (bf16_t)f2bf(bfhi(v.w) * kw); }
#pragma unroll
    for (int j = 0; j < 4; ++j) { const int ci = tid + 512 * j, row = ci & 127, c = ci >> 7; const u32x4 v = *(const u32x4*)(P + (tok0 + row) * PP + C_RV + hd * 128 + 8 * c);
        LAS unsigned char* d = Vt + (8 * c) * 272 + row * 2;
        *(LAS bf16_t*)(d + 0 * 272) = (bf16_t)(v.x & 0xffff); *(LAS bf16_t*)(d + 1 * 272) = (bf16_t)(v.x >> 16);
        *(LAS bf16_t*)(d + 2 * 272) = (bf16_t)(v.y & 0xffff); *(LAS bf16_t*)(d + 3 * 272) = (bf16_t)(v.y >> 16);
        *(LAS bf16_t*)(d + 4 * 272) = (bf16_t)(v.z & 0xffff); *(LAS bf16_t*)(d + 5 * 272) = (bf16_t)(v.z >> 16);
        *(LAS bf16_t*)(d + 6 * 272) = (bf16_t)(v.w & 0xffff); *(LAS bf16_t*)(d + 7 * 272) = (bf16_t)(v.w >> 16); }
    __syncthreads();
    const int dkh = wid & 1, dvq = wid >> 1;
    f32x16 acc;
#pragma unroll
    for (int i = 0; i < 16; ++i) acc[i] = 0.f;
#pragma unroll
    for (int s = 0; s < 8; ++s) { const bf16x8 af = *(const LAS bf16x8*)(Kt + (32 * dkh + r) * 272 + (16 * s + 8 * h) * 2); const bf16x8 bfr = *(const LAS bf16x8*)(Vt + (32 * dvq + r) * 272 + (16 * s + 8 * h) * 2); acc = MFMA32(bfr, af, acc); }
    bf16_t* o = RS + ((size_t)((b * 32 + n) * 4 + hd)) * 8192;
#pragma unroll
    for (int i = 0; i < 16; ++i) o[(32 * dvq + crow(i, h)) * 64 + 32 * dkh + r] = (bf16_t)f2bf(acc[i]);
}
DI void ret_out_unit(LAS unsigned char* lds, bf16_t* P, const bf16_t* PV, int u) {
    const int b = u >> 7, n = (u >> 2) & 31, hd = u & 3;
    int tid = my_tid(); asm volatile("" : "+v"(tid)); const int lane = tid & 63, r = lane & 31, h = lane >> 5, wid = __builtin_amdgcn_readfirstlane(tid >> 6);
    LAS unsigned char* Ks = lds; LAS unsigned char* Vt = lds + 18432; LAS unsigned char* PvT = lds + 18432 + 34816; LAS float* Y = (LAS float*)lds;
    const size_t tok0 = (size_t)b * SEQ + n * 128; const float l2g = ret_log2g(hd);
    __syncthreads();
    {
        const bf16_t* pv = PV + ((size_t)((b * 32 + n) * 4 + hd)) * 8192;
#pragma unroll
        for (int j = 0; j < 2; ++j) { const int ci = tid + 512 * j, dv = ci >> 3, c = ci & 7; *(LAS u32x4*)(PvT + dv * 144 + c * 16) = *(const u32x4*)(pv + dv * 64 + c * 8); }
    }
#pragma unroll
    for (int j = 0; j < 2; ++j) { const int ci = tid + 512 * j, row = ci >> 3, c = ci & 7; *(LAS u32x4*)(Ks + row * 144 + c * 16) = *(const u32x4*)(P + (tok0 + row) * PP + C_RK + hd * 64 + 8 * c); }
#pragma unroll
    for (int j = 0; j < 4; ++j) { const int ci = tid + 512 * j, row = ci & 127, c = ci >> 7; const u32x4 v = *(const u32x4*)(P + (tok0 + row) * PP + C_RV + hd * 128 + 8 * c);
        LAS unsigned char* d = Vt + (8 * c) * 272 + vpos(row) * 2;
        *(LAS bf16_t*)(d + 0 * 272) = (bf16_t)(v.x & 0xffff); *(LAS bf16_t*)(d + 1 * 272) = (bf16_t)(v.x >> 16);
        *(LAS bf16_t*)(d + 2 * 272) = (bf16_t)(v.y & 0xffff); *(LAS bf16_t*)(d + 3 * 272) = (bf16_t)(v.y >> 16);
        *(LAS bf16_t*)(d + 4 * 272) = (bf16_t)(v.z & 0xffff); *(LAS bf16_t*)(d + 5 * 272) = (bf16_t)(v.z >> 16);
        *(LAS bf16_t*)(d + 6 * 272) = (bf16_t)(v.w & 0xffff); *(LAS bf16_t*)(d + 7 * 272) = (bf16_t)(v.w >> 16); }
    const int wq = wid & 3, wd = wid >> 2;
    bf16x8 qf[4];
#pragma unroll
    for (int s = 0; s < 4; ++s) qf[s] = *(const bf16x8*)(P + (tok0 + 32 * wq + r) * PP + C_RQ + hd * 64 + 16 * s + 8 * h);
    __syncthreads();
    f32x16 O[2], Oc[2];
#pragma unroll
    for (int i = 0; i < 16; ++i) { O[0][i] = 0.f; O[1][i] = 0.f; Oc[0][i] = 0.f; Oc[1][i] = 0.f; }
    for (int kb = 0; kb <= wq; ++kb) {
        f32x16 p;
#pragma unroll
        for (int i = 0; i < 16; ++i) p[i] = 0.f;
#pragma unroll
        for (int s = 0; s < 4; ++s) { const bf16x8 a = *(const LAS bf16x8*)(Ks + (32 * kb + r) * 144 + (16 * s + 8 * h) * 2); p = MFMA32(a, qf[s], p); }
        const int qi = 32 * wq + r;
#pragma unroll
        for (int i = 0; i < 16; ++i) { const int d = qi - (32 * kb + crow(i, h)); p[i] = (d >= 0) ? p[i] * ex2(l2g * (float)d) : 0.f; }
#pragma unroll
        for (int s2 = 0; s2 < 2; ++s2) { const bf16x8 pa = packp(p, 8 * s2);
#pragma unroll
            for (int dh = 0; dh < 2; ++dh) { const bf16x8 vb = *(const LAS bf16x8*)(Vt + (64 * wd + 32 * dh + r) * 272 + (32 * kb + 16 * s2 + 8 * h) * 2); O[dh] = MFMA32(pa, vb, O[dh]); } }
    }
#pragma unroll
    for (int s = 0; s < 4; ++s)
#pragma unroll
        for (int dh = 0; dh < 2; ++dh) { const bf16x8 pb = *(const LAS bf16x8*)(PvT + (64 * wd + 32 * dh + r) * 144 + (16 * s + 8 * h) * 2); Oc[dh] = MFMA32(qf[s], pb, Oc[dh]); }
    __syncthreads();
#pragma unroll
    for (int i = 0; i < 16; ++i) { const int q = 32 * wq + crow(i, h); const float qw = ex2(l2g * (float)(q + 1));
#pragma unroll
        for (int dh = 0; dh < 2; ++dh) Y[q * 132 + 64 * wd + 32 * dh + r] = O[dh][i] + qw * Oc[dh][i]; }
    __syncthreads();
    {
        const int q = tid >> 2, part = tid & 3; const LAS float* yr = Y + q * 132 + part * 32;
        float s = 0.f;
#pragma unroll
        for (int j = 0; j < 32; ++j) s += yr[j];
        s += __shfl_xor(s, 1); s += __shfl_xor(s, 2);
        const float mu = s * (1.f / 128.f); float vs = 0.f;
#pragma unroll
        for (int j = 0; j < 32; ++j) { const float d = yr[j] - mu; vs += d * d; }
        vs += __shfl_xor(vs, 1); vs += __shfl_xor(vs, 2);
        const float rstd = rsqrtf(vs * (1.f / 128.f) + EPS);
        bf16_t* gp = P + (tok0 + q) * PP + C_RG + hd * 128 + part * 32;
#pragma unroll
        for (int c = 0; c < 4; ++c) { const u32x4 gv = *(const u32x4*)(gp + 8 * c); const unsigned gw[4] = {gv.x, gv.y, gv.z, gv.w}; u32x4 o; unsigned ow[4];
#pragma unroll
            for (int e = 0; e < 4; ++e) { const float g0 = bflo(gw[e]), g1 = bfhi(gw[e]); const float y0 = (yr[8 * c + 2 * e] - mu) * rstd, y1 = (yr[8 * c + 2 * e + 1] - mu) * rstd;
                ow[e] = pk2(g0 * sigmoidf_(g0) * y0, g1 * sigmoidf_(g1) * y1); }
            o.x = ow[0]; o.y = ow[1]; o.z = ow[2]; o.w = ow[3]; *(u32x4*)(gp + 8 * c) = o; }
    }
}

DI void s5_scan(const bf16_t* LEb, bf16_t* Xp, const float* aTall, int pair, int lane) {
    const int b = pair >> 5, g = pair & 31; const float* aT = aTall + g * 128;
    const float ar = aT[lane], ai = aT[64 + lane]; float xr = 0.f, xi = 0.f;
    const size_t R0 = (size_t)g * 1024 + (size_t)b * 128;
    for (int n0 = 0; n0 < 128; n0 += 8) {
        float lr[8], li[8];
#pragma unroll
        for (int j = 0; j < 8; ++j) { lr[j] = bf2f(LEb[(R0 + n0 + j) * 128 + lane]); li[j] = bf2f(LEb[(R0 + n0 + j) * 128 + 64 + lane]); }
#pragma unroll
        for (int j = 0; j < 8; ++j) { Xp[(R0 + n0 + j) * 128 + lane] = (bf16_t)f2bf(xr); Xp[(R0 + n0 + j) * 128 + 64 + lane] = (bf16_t)f2bf(xi);
            const float nr = ar * xr - ai * xi + lr[j], ni = ar * xi + ai * xr + li[j]; xr = nr; xi = ni; }
    }
}
DI void ret_prefix(const bf16_t* RS, bf16_t* PV, int tt) {
    const int bh = tt >> 12, pr = tt & 4095, b = bh >> 2, hd = bh & 3;
    const float cd = ex2(ret_log2g(hd) * 128.f);
    const unsigned* src = (const unsigned*)RS + ((size_t)(b * 32) * 4 + hd) * 4096 + pr; unsigned* dst = (unsigned*)PV + ((size_t)(b * 32) * 4 + hd) * 4096 + pr;
    float s0 = 0.f, s1 = 0.f;
    for (int n0 = 0; n0 < 32; n0 += 8) {
        unsigned w[8];
#pragma unroll
        for (int j = 0; j < 8; ++j) w[j] = src[(size_t)(n0 + j) * 4 * 4096];
#pragma unroll
        for (int j = 0; j < 8; ++j) { dst[(size_t)(n0 + j) * 4 * 4096] = pk2(s0, s1); s0 = s0 * cd + bflo(w[j]); s1 = s1 * cd + bfhi(w[j]); }
    }
}

#define XB_TMO      128
#define XB_XCNT(j)  (256  + 64 * (j))
#define XB_XSUB(j)  (1280 + 64 * (j))
#define XB_XGEN(j)  (2304 + 64 * (j))
#define XB_TOP      3328
#define XB_TOPGEN   3392
#define XCD_BAR_WORDS 3456
#define XB_SPIN_CAP (1u << 20)
DI unsigned xb_ld(unsigned* p)              { return __hip_atomic_load(p, __ATOMIC_RELAXED, __HIP_MEMORY_SCOPE_AGENT); }
DI unsigned xb_add(unsigned* p, unsigned v) { return __hip_atomic_fetch_add(p, v, __ATOMIC_RELAXED, __HIP_MEMORY_SCOPE_AGENT); }
DI unsigned xb_xcc_id() { return (unsigned)__builtin_amdgcn_s_getreg((3 << 11) | 20) & 0xFu; }
#define XB_SPIN(cond, bar) do { unsigned _sp = 0; while (cond) { __builtin_amdgcn_s_sleep(1); \
    if ((++_sp & 255u) == 0u) { if (xb_ld(&(bar)[XB_TMO])) break; if (_sp > XB_SPIN_CAP) { atomicAdd(&(bar)[XB_TMO], 1u); break; } } } } while (0)
struct XcdBarrier { unsigned* bar; unsigned x; volatile LAS unsigned* st; };
DI XcdBarrier xcd_barrier_post(unsigned* bar, volatile LAS unsigned* st) {
    XcdBarrier b; b.bar = bar; b.x = xb_xcc_id(); b.st = st;
    if (my_tid() == 0) (void)xb_add(&bar[XB_XCNT(b.x)], 1u);
    return b;
}
DI void xcd_barrier_complete(unsigned* bar, unsigned x, unsigned& nloc, unsigned& nx) {
    const unsigned G = gridDim.x * gridDim.y * gridDim.z;
    unsigned sum, cnt, mine, sp = 0u;
    for (;;) {
        sum = 0u; cnt = 0u; mine = 0u;
#pragma unroll
        for (unsigned j = 0; j < 16; ++j) { const unsigned c = xb_ld(&bar[XB_XCNT(j)]); sum += c; cnt += (c > 0u) ? 1u : 0u; mine = (j == x) ? c : mine; }
        if (sum == G) break;
        __builtin_amdgcn_s_sleep(1);
        if ((++sp & 255u) == 0u) { if (xb_ld(&bar[XB_TMO])) break; if (sp > XB_SPIN_CAP) { atomicAdd(&bar[XB_TMO], 1u); break; } }
    }
    nloc = mine > 0u ? mine : 1u; nx = cnt > 0u ? cnt : 1u;
}
DI void xcd_barrier(const XcdBarrier& b) {
    asm volatile("s_waitcnt vmcnt(0)" ::: "memory");
    __syncthreads();
    if (my_tid() == 0) {
        unsigned* bar = b.bar;
        __builtin_amdgcn_s_waitcnt(0);
        unsigned nloc = b.st[0], nx = b.st[1];
        if (nloc == 0u) { xcd_barrier_complete(bar, b.x, nloc, nx); b.st[0] = nloc; b.st[1] = nx; }
        const unsigned old = xb_add(&bar[XB_XSUB(b.x)], 1u);
        const unsigned gen = old / nloc;
        if (old + 1u == (gen + 1u) * nloc) {
            __builtin_amdgcn_fence(__ATOMIC_RELEASE, "agent");
            asm volatile("s_waitcnt vmcnt(0)" ::: "memory");
            const unsigned og = xb_add(&bar[XB_TOP], 1u);
            const unsigned tg = og / nx;
            if (og + 1u == (tg + 1u) * nx) xb_add(&bar[XB_TOPGEN], 1u);
            else XB_SPIN(xb_ld(&bar[XB_TOPGEN]) == tg, bar);
            __builtin_amdgcn_fence(__ATOMIC_ACQUIRE, "agent");
            xb_add(&bar[XB_XGEN(b.x)], 1u);
            asm volatile("s_waitcnt vmcnt(0)" ::: "memory");
        } else {
            XB_SPIN(xb_ld(&bar[XB_XGEN(b.x)]) == gen, bar);
            __builtin_amdgcn_fence(__ATOMIC_ACQUIRE, "agent");
            asm volatile("s_waitcnt vmcnt(0)" ::: "memory");
        }
    }
    __syncthreads();
}

constexpr int LDS_BYTES = 131072 + 4096;
constexpr int NPH = 23;

__global__ void __launch_bounds__(512, 2) mega(Args a) {
    LAS unsigned char* lds = (LAS unsigned char*)lds_raw;
    if ((threadIdx.x & 63) == 0) *(volatile LAS int*)(lds + TIDTAB_OFF + hw_wave_slot() * 4) = (int)(threadIdx.x >> 6);
    __syncthreads();
    volatile LAS unsigned* bst = (volatile LAS unsigned*)(lds + 131072 + 1024);
    XcdBarrier xbar; xbar.bar = (unsigned*)(a.ws + OFF_BAR); xbar.x = 0; xbar.st = bst;
    if (a.ph_hi - a.ph_lo > 1) { if (my_tid() == 0) { bst[0] = 0u; bst[1] = 0u; } __syncthreads(); xbar = xcd_barrier_post((unsigned*)(a.ws + OFF_BAR), bst); }
    for (int it = a.ph_lo; it < a.ph_hi; ++it) {
        const int ph = it < 0 ? it + PROBE_PRE : it; const bool pre = it < 0; (void)pre;
        unsigned char* ws = a.ws; asm volatile("" : "+s"(ws));
        int G = gridDim.x, bid = blockIdx.x; asm volatile("" : "+s"(G), "+s"(bid));
        const int vcu = (G % 8 == 0) ? (bid & 7) * (G >> 3) + (bid >> 3) : bid;
        bf16_t* XN = (bf16_t*)(ws + OFF_XN); bf16_t* P = (bf16_t*)(ws + OFF_P); bf16_t* Qm = (bf16_t*)(ws + OFF_QM); bf16_t* KV = (bf16_t*)(ws + OFF_KV);
        bf16_t* RS = (bf16_t*)(ws + OFF_RS); bf16_t* PV = (bf16_t*)(ws + OFF_PV); bf16_t* LEb = (bf16_t*)(ws + OFF_LE); bf16_t* Xp = (bf16_t*)(ws + OFF_XP);
        const float2* ropeH = (const float2*)(ws + OFF_ROPEH); const float2* ropeR = (const float2*)(ws + OFF_ROPER);
        float* SSQ = (float*)(ws + OFF_SSQ);
        if (ph == 0) {
            int tid = my_tid(); asm volatile("" : "+v"(tid));
            for (int e = bid * 512 + tid; e < SEQ * 48; e += G * 512) {
                if (e < SEQ * 32) { const int pos = e >> 5, i = e & 31; const float inv = exp2f(-(float)i * (13.287712379549449f / 32.f)); float sn, cs; sincosf((float)pos * inv, &sn, &cs); ((float2*)(ws + OFF_ROPEH))[e] = make_float2(cs, sn); }
                else { const int e2 = e - SEQ * 32, pos = e2 >> 4, i = e2 & 15; const float inv = exp2f(-(float)i * (13.287712379549449f / 16.f)); float sn, cs; sincosf((float)pos * inv, &sn, &cs); ((float2*)(ws + OFF_ROPER))[e2] = make_float2(cs, sn); }
            }
            s5_tables(a, 0, lds);
            __syncthreads();
            prep_weights(a, 0, lds);
            norm_rows_first(a.in[0], a.in[1], XN);
        } else {
            const int l = (ph - 1) / 11, sp0 = (ph - 1) % 11; const int sp = sp0 < 2 ? sp0 : sp0 - 1;
            float* ssq_q = SSQ; float* ssq_kv = SSQ + (size_t)8 * M; float* ssq_z = SSQ + (size_t)16 * M; float* ssq_f = SSQ + (size_t)32 * M;
            if (sp0 == 2) {
                int tid = my_tid(); asm volatile("" : "+v"(tid));
                if (tid < 64) for (int pair = bid; pair < 256; pair += G) s5_scan(LEb, Xp, (const float*)(ws + OFF_AT), pair, tid);
                for (int tt = bid * 512 + tid; tt < 131072; tt += G * 512) ret_prefix(RS, PV, tt);
            } else if (sp == 0) {
                eng::PlainSched S{(const char*)XN, (const char*)(ws + W_IN), 2048, 2048, 16, 128, 13, G, bid, 128, (size_t)256 * 2048};
                EpiInProj E{P, ropeH, ropeR, ssq_q, ssq_kv};
                eng::gemm_phase(lds, S, E);
            } else if (sp == 1) {
                if (!(pre && (PROBE_SKIP & 8))) { eng::PlainSched S{(const char*)(P + C_CQ), (const char*)(ws + W_UQ), PP * 2, 512, 4, 128, 3, G, bid, 128, (size_t)256 * PP * 2}; EpiQup E{Qm, ropeR, ssq_q}; eng::gemm_phase(lds, S, E); }
                if (!(pre && (PROBE_SKIP & 8))) { eng::PlainSched S{(const char*)(P + C_CKV), (const char*)(ws + W_UKV), PP * 2, 256, 2, 128, 4, G, bid, 128, (size_t)256 * PP * 2}; EpiKVup E{KV, ssq_kv}; eng::gemm_phase(lds, S, E); }
                if (!(pre && (PROBE_SKIP & 16))) { S5StateSched S{(const char*)P, (const char*)(ws + OFF_WST), G, vcu}; EpiLE E{LEb}; eng::gemm_phase(lds, S, E); }
                if (!(pre && (PROBE_SKIP & 32))) for (int u = bid; u < 1024; u += G) ret_state_unit(lds, P, RS, u);
                __syncthreads();
                const float* sinks = a.in[6] + l * 8;
                if (!(pre && (PROBE_SKIP & 64))) for (int u = vcu; u < 1024; u += G) { const int hd = (u >> 4) & 7; attn_unit<1>(lds, u >> 7, hd, u & 15, P, Qm, KV, sinks[hd] * LOG2E); }
            } else if (sp == 2) {
                if (!(pre && (PROBE_SKIP & 1))) for (int u = vcu; u < 1024; u += G) { const int i = u >> 8, v = u & 255, bh = v >> 2, s = v & 3; const int qb = i == 0 ? s : i == 1 ? 7 - s : i == 2 ? 8 + s : 15 - s;
                    attn_unit<0>(lds, bh >> 3, bh & 7, qb, P, Qm, KV, 0.f); }
                if (!(pre && (PROBE_SKIP & 2))) for (int u = bid; u < 1024; u += G) ret_out_unit(lds, P, PV, u);
                __syncthreads();
                if (!(pre && (PROBE_SKIP & 4))) { S5OutSched S{(const char*)P, (const char*)Xp, (const char*)(ws + OFF_TZ), (const char*)(ws + OFF_MC), G, vcu}; EpiS5Out E{P, a.in[14] + l * 512}; eng::gemm_phase(lds, S, E); }
            } else if (sp == 3) {
                GluSched S{(const char*)P, (const char*)(ws + W_GLU), G, bid};
                EpiGlu E{P}; eng::gemm_phase(lds, S, E);
            } else if (sp == 4) {
                MergeSched S{(const char*)XN, (const char*)(ws + W_GATE), (const char*)(ws + W_BR), (const char*)P, (const char*)Qm, G, bid};
                u32x4* scr = (u32x4*)(ws + OFF_SCR) + (size_t)bid * 2 * 16 * 512;
                EpiMerge E{KV, scr, scr + 16 * 512}; eng::gemm_phase(lds, S, E);
            } else if (sp == 5) {
                eng::PlainSched S{(const char*)KV, (const char*)(ws + W_OUT), 2048, 2048, 16, 128, 4, G, bid, 128, (size_t)256 * 2048};
                EpiZ E{P, ssq_z}; eng::gemm_phase(lds, S, E);
            } else if (sp == 6) {
                if (l == 0) norm_rows_res<false, true>(a.in[0], P, ssq_z, a.in[2] + l * DM, KV, a.in[3] + l * DM, XN);
                else norm_rows_res<true, true>(a.out, P, ssq_z, a.in[2] + l * DM, KV, a.in[3] + l * DM, XN);
            } else if (sp == 7) {
                eng::PlainSched S{(const char*)XN, (const char*)(ws + W_FF1), 2048, 2048, 16, 128, 16, G, bid, 128, (size_t)256 * 2048};
                EpiFF1 E{P}; eng::gemm_phase(lds, S, E);
            } else if (sp == 8) {
                eng::PlainSched S{(const char*)P, (const char*)(ws + W_FF2), 128, HP * 2, 64, 128, 4, G, bid, 32768, (size_t)64 * 32768};
                EpiZ E{XN, ssq_f}; eng::gemm_phase(lds, S, E);
            } else {
                if (l + 1 < 2) norm_rows_res<true, true>(KV, XN, ssq_f, a.in[4] + l * DM, a.out, a.in[1] + (l + 1) * DM, XN);
                else norm_rows_res<true, false>(KV, XN, ssq_f, a.in[4] + l * DM, a.out, nullptr, XN);
                if (l + 1 < 2) { __syncthreads(); s5_tables(a, l + 1, lds); __syncthreads(); prep_weights(a, l + 1, lds); }
            }
        }
        if (it + 1 < a.ph_hi) { if (a.ph_hi > NPH) { __threadfence(); cg::this_grid().sync(); }
            xcd_barrier(xbar); }
    }
}

extern "C" void kernel_launch(void* const* d_in, const int* in_sizes, int n_in, void* d_out, int out_size, void* d_ws, size_t ws_size, hipStream_t stream) {
    static int grid = 0;
    if (grid == 0) {
        if (n_in != 24 || ws_size < WS_NEED) { fprintf(stderr, "kernel_launch: unexpected n_in %d / ws_size %zu\n", n_in, ws_size); grid = -1; return; }
        int dev = 0, cus = 0, per_cu = 0;
        hipGetDevice(&dev); hipDeviceGetAttribute(&cus, hipDeviceAttributeMultiprocessorCount, dev);
        hipFuncSetAttribute((const void*)mega, hipFuncAttributeMaxDynamicSharedMemorySize, LDS_BYTES);
        hipOccupancyMaxActiveBlocksPerMultiprocessor(&per_cu, (const void*)mega, 512, LDS_BYTES);
        if (per_cu < 1) { fprintf(stderr, "kernel_launch: occupancy query returned %d\n", per_cu); per_cu = 1; }
        (void)hipGetLastError();
        grid = cus;
    }
    if (grid < 0) return;
    Args a{};
    for (int i = 0; i < 24; ++i) a.in[i] = (const float*)d_in[i];
    a.out = (float*)d_out; a.ws = (unsigned char*)d_ws;
#if N_LAUNCH_MODE == 1
    hipMemsetAsync((char*)d_ws + OFF_BAR, 0, 16384, stream);
    a.ph_lo = -PROBE_PRE; a.ph_hi = NPH;
    void* args[] = {&a};
    hipError_t e = hipLaunchCooperativeKernel((const void*)mega, dim3(grid), dim3(512), args, LDS_BYTES, stream);
    if (e != hipSuccess) fprintf(stderr, "cooperative launch failed: %s (grid %d)\n", hipGetErrorString(e), grid);
#else
    for (int ph = 0; ph < NPH; ++ph) { a.ph_lo = ph; a.ph_hi = ph + 1; hipLaunchKernelGGL(mega, dim3(grid), dim3(512), LDS_BYTES, stream, a); }
#endif
}
```

```cpp
#include <hip/hip_runtime.h>
#include <hip/hip_cooperative_groups.h>
#include <cstdio>
#include <cstdint>
namespace cg = cooperative_groups;

#ifndef N_LAUNCH_MODE
#define N_LAUNCH_MODE 1
#endif

#ifndef PROBE_SKIP
#define PROBE_SKIP 0
#endif
#ifndef PROBE_PRE
#define PROBE_PRE 0
#endif

#define LAS __attribute__((address_space(3)))
#define DI __device__ __forceinline__
typedef unsigned short bf16_t;
typedef short bf16x8 __attribute__((ext_vector_type(8)));
typedef float f32x4 __attribute__((ext_vector_type(4)));
typedef float f32x16 __attribute__((ext_vector_type(16)));
typedef unsigned u32x4 __attribute__((ext_vector_type(4)));
typedef unsigned u32x2 __attribute__((ext_vector_type(2)));

constexpr int M = 32768, SEQ = 4096, NBATCH = 8, DM = 1024, DFF = 4096, DIN = 7328;
constexpr int HP = 4096 + 64;
constexpr int PP = 3328;
constexpr int C_SQ = 0, C_SK = 512, C_SV = 640, C_U = 768, C_RQ = 1280, C_RK = 1536, C_RV = 1792, C_RG = 2304, C_CQ = 2816, C_CKV = 3072, C_KR = 3200;
constexpr float EPS = 1e-6f;
constexpr float LOG2E = 1.4426950408889634f;

constexpr size_t MiB = 1u << 20;
constexpr size_t W_IN = 0, W_GATE = W_IN + (size_t)3328 * 1024 * 2, W_GLU = W_GATE + (size_t)4096 * 1024 * 2, W_UQ = W_GLU + (size_t)1024 * 512 * 2,
                 W_UKV = W_UQ + (size_t)768 * 256 * 2, W_BR = W_UKV + (size_t)1024 * 128 * 2, W_OUT = W_BR + (size_t)4 * 1024 * 512 * 2,
                 W_FF1 = W_OUT + (size_t)1024 * 1024 * 2, W_FF2 = W_FF1 + (size_t)4096 * 1024 * 2, W_END = W_FF2 + (size_t)HP * 1024 * 2;
static_assert(W_END <= 40 * MiB, "weights");
constexpr size_t OFF_ROPEH = 40 * MiB, OFF_ROPER = 41 * MiB, OFF_XN = 43 * MiB, OFF_P = 107 * MiB, OFF_QM = 315 * MiB, OFF_KV = 363 * MiB,
                 OFF_RS = 427 * MiB, OFF_LE = 459 * MiB, OFF_TZ = 475 * MiB, OFF_MC = 491 * MiB, OFF_WST = 495 * MiB, OFF_AT = 499 * MiB, OFF_SSQ = 500 * MiB, OFF_BAR = 508 * MiB, WS_NEED = 509 * MiB;
constexpr size_t OFF_PV = OFF_RS + 16 * MiB;
constexpr size_t OFF_XP = OFF_LE + 8 * MiB;
constexpr size_t OFF_SCR = OFF_RS;

struct Args {
    const float* in[24];
    float* out; unsigned char* ws;
    int ph_lo, ph_hi;
};

typedef float f32x2_t __attribute__((ext_vector_type(2))); typedef __bf16 bf16x2_t __attribute__((ext_vector_type(2)));
DI unsigned pk2(float lo, float hi) { f32x2_t v = {lo, hi}; bf16x2_t b = __builtin_convertvector(v, bf16x2_t); return __builtin_bit_cast(unsigned, b); }
DI unsigned f2bf(float f) { return pk2(f, 0.f) & 0xffffu; }
DI float bflo(unsigned w) { return __builtin_bit_cast(float, w << 16); }
DI float bfhi(unsigned w) { return __builtin_bit_cast(float, w & 0xffff0000u); }
DI float bf2f(bf16_t b) { return __builtin_bit_cast(float, (unsigned)b << 16); }
DI float ex2(float x) { return __builtin_amdgcn_exp2f(x); }
DI float sigmoidf_(float x) { return __builtin_amdgcn_rcpf(1.f + ex2(-x * LOG2E)); }
DI int crow(int r, int hi) { return (r & 3) + 8 * (r >> 2) + 4 * hi; }
DI float wave_sum(float v) {
#pragma unroll
    for (int o = 1; o < 64; o <<= 1) v += __shfl_xor(v, o);
    return v;
}
#define MFMA32(a, b, c) __builtin_amdgcn_mfma_f32_32x32x16_bf16((a), (b), (c), 0, 0, 0)
DI bf16x8 packp(const f32x16& p, int base) {
    u32x4 w; w.x = pk2(p[base + 0], p[base + 1]); w.y = pk2(p[base + 2], p[base + 3]); w.z = pk2(p[base + 4], p[base + 5]); w.w = pk2(p[base + 6], p[base + 7]);
    return __builtin_bit_cast(bf16x8, w);
}
DI int vpos(int kv) { const int t = kv & 15; return (kv & ~15) + 8 * ((t >> 2) & 1) + 4 * (t >> 3) + (t & 3); }

extern __shared__ __attribute__((aligned(16))) unsigned char lds_raw[];
constexpr int TIDTAB_OFF = 131072 + 1280;
DI unsigned hw_wave_slot() { return (unsigned)__builtin_amdgcn_s_getreg((5 << 11) | 4) & 63u; }
DI int my_tid() {
    const int w = *(volatile LAS int*)((LAS unsigned char*)lds_raw + TIDTAB_OFF + hw_wave_slot() * 4);
    unsigned ones = ~0u; asm volatile("" : "+s"(ones));
    return __builtin_amdgcn_readfirstlane(w) * 64 + (int)__builtin_amdgcn_mbcnt_hi(ones, __builtin_amdgcn_mbcnt_lo(ones, 0u));
}

namespace eng {
constexpr int BM = 256, BK = 64, HALF = 128, HTB = HALF * BK * 2, STAGE_BYTES = 8 * HTB, NXCD = 8, WGM = 8;
DI int lds_byte(int r, int c) { const int st = (r >> 4) * 2 + (c >> 5), rr = r & 15, cc = c & 31, ob = rr * 64 + cc * 2; return st * 1024 + (ob ^ (((ob >> 9) & 1) << 5)); }
DI void stage_rc(int b, int& R, int& C) { const int st = b / 1024, sb = b % 1024, swz = sb ^ (((sb >> 9) & 1) << 5); R = (st >> 1) * 16 + swz / 64; C = (st & 1) * 32 + (swz % 64) / 2; }
DI int perm32(int rho) { const int n = rho >> 4, i = rho & 15; return 8 * (i >> 2) + 4 * n + (i & 3); }

struct Unit { const char* A; const char* B; int ldaB, kB, nt, pm, pn, tag, ksA; };

DI bool tile_of(int i, int G, int c, int nM, int nN, int& pm, int& pn) {
    const int nwg = nM * nN; const long L = (long)i * G + c; if (L >= nwg) return false;
    int wgid = (int)L; { const int q = nwg / NXCD, r = nwg % NXCD, xcd = wgid % NXCD, off = wgid / NXCD; wgid = (xcd < r ? xcd * (q + 1) : r * (q + 1) + (xcd - r) * q) + off; }
    const int nig = WGM * nN, gid = wgid / nig, fm = gid * WGM, gsz = (nM - fm) < WGM ? (nM - fm) : WGM;
    pm = fm + ((wgid % nig) % gsz); pn = (wgid % nig) / gsz; return true;
}
struct PlainSched {
    const char* A; const char* B; int ldaB, kB, nt, nM, nN, G, c; int ksA; size_t tileA;
    DI bool next(int i, Unit& u) const {
        int pm, pn; if (!tile_of(i, G, c, nM, nN, pm, pn)) return false;
        u.pm = pm; u.pn = pn; u.tag = 0; u.ldaB = ldaB; u.kB = kB; u.nt = nt; u.ksA = ksA; u.A = A + (size_t)pm * tileA; u.B = B + (size_t)pn * 256 * kB; return true;
    }
};

template <bool ALIGN = true, class Epi, class Sched>
DI void gemm_phase(LAS unsigned char* lds, const Sched& S, const Epi& E) {
    int tid = my_tid(); asm volatile("" : "+v"(tid));
    const int wid = __builtin_amdgcn_readfirstlane(tid >> 6), lane = tid & 63, wr = wid >> 2, wc = wid & 3, fr = lane & 15, fq = lane >> 4;
    int R0, C0; stage_rc(tid * 16, R0, C0);
    const int Rb0 = (R0 & ~31) + perm32(R0 & 31);
    const unsigned ldsw = (unsigned)wid * 1024u;
    const int aoff = lds_byte(wr * 64 + fr, fq * 8), boff = lds_byte(wc * 32 + fr, fq * 8);
    constexpr size_t kstep = (size_t)(BK * 2);
#define PG8_SA(b, h) (((b) * 2 + (h)) * HTB)
#define PG8_SB(b, h) ((4 + (b) * 2 + (h)) * HTB)
#define PG8_STAGE(bufoff, gbase, v0, s64) do { \
        __builtin_amdgcn_global_load_lds((const unsigned*)((const char*)(gbase) + (v0)), (LAS unsigned*)(lds + (bufoff) + ldsw), 16, 0, 0); \
        __builtin_amdgcn_global_load_lds((const unsigned*)((const char*)(gbase) + (v0) + (s64)), (LAS unsigned*)(lds + (bufoff) + ldsw + 8192), 16, 0, 0); } while (0)
#define PG8_LDA(dst, b, h) do { _Pragma("unroll") for (int m = 0; m < 4; ++m) _Pragma("unroll") for (int k = 0; k < 2; ++k) dst[m][k] = *(const LAS bf16x8*)(lds + PG8_SA(b, h) + aoff + m * 2048 + k * 1024); } while (0)
#define PG8_LDB(dst, b, h) do { _Pragma("unroll") for (int n = 0; n < 2; ++n) _Pragma("unroll") for (int k = 0; k < 2; ++k) dst[n][k] = *(const LAS bf16x8*)(lds + PG8_SB(b, h) + boff + n * 2048 + k * 1024); } while (0)
#define PG8_MMA(ai, bj, At, Bt) do { __builtin_amdgcn_s_setprio(1); _Pragma("unroll") for (int m = 0; m < 4; ++m) _Pragma("unroll") for (int n = 0; n < 2; ++n) _Pragma("unroll") for (int k = 0; k < 2; ++k) \
        acc[ai][bj][m][n] = __builtin_amdgcn_mfma_f32_16x16x32_bf16(Bt[n][k], At[m][k], acc[ai][bj][m][n], 0, 0, 0); __builtin_amdgcn_s_setprio(0); } while (0)
#define PG8_WAIT_V(n) asm volatile("s_waitcnt vmcnt(" #n ")" ::: "memory")
#define PG8_WAIT_L(n) asm volatile("s_waitcnt lgkmcnt(" #n ")" ::: "memory")
#define PG8_BAR __builtin_amdgcn_s_barrier()
#define PG8_SCHED __builtin_amdgcn_sched_barrier(0)
    Unit cur, nxt; int ui = 0;
    if (!S.next(0, cur)) return;
    f32x4 acc[2][2][4][2];
#pragma unroll
    for (int a = 0; a < 2; ++a)
#pragma unroll
        for (int b = 0; b < 2; ++b)
#pragma unroll
            for (int m = 0; m < 4; ++m)
#pragma unroll
                for (int n = 0; n < 2; ++n) acc[a][b][m][n] = (f32x4){0.f, 0.f, 0.f, 0.f};
    bf16x8 At[4][2], B0[2][2], B1[2][2];
    const char* cA = cur.A; const char* cB = cur.B;
    unsigned vA = (unsigned)(R0 * cur.ldaB + C0 * 2), vB = (unsigned)(Rb0 * cur.kB + C0 * 2), sA = (unsigned)(64 * cur.ldaB), sB = (unsigned)(64 * cur.kB);
    {
        const size_t hA = 2 * (size_t)sA, hB = 2 * (size_t)sB;
        PG8_STAGE(PG8_SB(0, 0), cB, vB, sB); PG8_STAGE(PG8_SB(0, 1), cB + hB, vB, sB); PG8_STAGE(PG8_SA(0, 0), cA, vA, sA); PG8_STAGE(PG8_SA(0, 1), cA + hA, vA, sA);
        if (wr == 1) PG8_BAR;
        PG8_WAIT_V(2); PG8_BAR;
        PG8_STAGE(PG8_SB(1, 0), cB + kstep, vB, sB); PG8_STAGE(PG8_SA(1, 0), cA + cur.ksA, vA, sA); PG8_STAGE(PG8_SB(1, 1), cB + hB + kstep, vB, sB);
        PG8_WAIT_V(6); PG8_BAR;
    }
    for (;;) {
        const bool has_next = S.next(ui + 1, nxt);
        const char* nA = has_next ? nxt.A : cA; const char* nB = has_next ? nxt.B : cB;
        const unsigned nvA = has_next ? (unsigned)(R0 * nxt.ldaB + C0 * 2) : vA, nvB = has_next ? (unsigned)(Rb0 * nxt.kB + C0 * 2) : vB;
        const unsigned nsA = has_next ? (unsigned)(64 * nxt.ldaB) : sA, nsB = has_next ? (unsigned)(64 * nxt.kB) : sB;
        const int nt = cur.nt; const size_t hA = 2 * (size_t)sA; const size_t ksA = (size_t)cur.ksA, nksA = has_next ? (size_t)nxt.ksA : ksA;
        for (int t = 0; t < nt; t += 2) {
            const bool last = (t == nt - 2);
            const char* a1 = cA + (size_t)(t + 1) * ksA;
            const char* a2 = last ? nA : cA + (size_t)(t + 2) * ksA; const char* b2 = last ? nB : cB + (size_t)(t + 2) * kstep;
            const char* a3 = a2 + (last ? nksA : ksA); const char* b3 = b2 + kstep;
            const unsigned vA2 = last ? nvA : vA, vB2 = last ? nvB : vB, sA2 = last ? nsA : sA, sB2 = last ? nsB : sB;
            const size_t hA2 = 2 * (size_t)sA2, hB2 = 2 * (size_t)sB2;
            PG8_LDB(B0, 0, 0); PG8_LDB(B1, 0, 1); PG8_SCHED; PG8_LDA(At, 0, 0); PG8_STAGE(PG8_SA(1, 1), a1 + hA, vA, sA);
            PG8_WAIT_V(8); PG8_WAIT_L(0); PG8_BAR; PG8_MMA(0, 0, At, B0); PG8_MMA(0, 1, At, B1); PG8_BAR; PG8_SCHED;
            PG8_LDA(At, 0, 1); PG8_STAGE(PG8_SB(0, 0), b2, vB2, sB2); PG8_STAGE(PG8_SB(0, 1), b2 + hB2, vB2, sB2); PG8_STAGE(PG8_SA(0, 0), a2, vA2, sA2);
            PG8_WAIT_V(8); PG8_WAIT_L(0); PG8_BAR; PG8_MMA(1, 0, At, B0); PG8_MMA(1, 1, At, B1); PG8_BAR; PG8_SCHED;
            PG8_LDB(B0, 1, 0); PG8_LDB(B1, 1, 1); PG8_SCHED; PG8_LDA(At, 1, 0); PG8_STAGE(PG8_SA(0, 1), a2 + hA2, vA2, sA2);
            PG8_WAIT_V(8); PG8_WAIT_L(0); PG8_BAR; PG8_MMA(0, 0, At, B0); PG8_MMA(0, 1, At, B1); PG8_BAR; PG8_SCHED;
            PG8_LDA(At, 1, 1); PG8_STAGE(PG8_SB(1, 0), b3, vB2, sB2); PG8_STAGE(PG8_SB(1, 1), b3 + hB2, vB2, sB2); PG8_STAGE(PG8_SA(1, 0), a3, vA2, sA2);
            PG8_WAIT_V(8); PG8_WAIT_L(0); PG8_BAR; PG8_MMA(1, 0, At, B0); PG8_MMA(1, 1, At, B1); PG8_BAR; PG8_SCHED;
        }
        if constexpr (ALIGN) { if (wr == 0) PG8_BAR; }
        const bool chain = (cur.tag & 0x100) != 0;
        if (!chain) { int t2 = my_tid(); asm volatile("" : "+v"(t2)); E(acc, cur, wr, wc, t2 & 15, (t2 >> 4) & 3); }
        if (!has_next) break;
        if (!chain)
#pragma unroll
        for (int a = 0; a < 2; ++a)
#pragma unroll
            for (int b = 0; b < 2; ++b)
#pragma unroll
                for (int m = 0; m < 4; ++m)
#pragma unroll
                    for (int n = 0; n < 2; ++n) acc[a][b][m][n] = (f32x4){0.f, 0.f, 0.f, 0.f};
        cur = nxt; cA = nA; cB = nB; vA = nvA; vB = nvB; sA = nsA; sB = nsB; ++ui;
        if constexpr (ALIGN) { if (wr == 1) PG8_BAR; }
    }
    PG8_WAIT_V(0);
    if constexpr (!ALIGN) { if (wr == 0) PG8_BAR; }
    PG8_BAR;
#undef PG8_SA
#undef PG8_SB
#undef PG8_STAGE
#undef PG8_LDA
#undef PG8_LDB
#undef PG8_MMA
#undef PG8_WAIT_V
#undef PG8_WAIT_L
#undef PG8_BAR
#undef PG8_SCHED
}
}
using eng::Unit;
typedef f32x4 AccT[2][2][4][2];

#define EPI_LOOP_BEGIN \
    _Pragma("unroll") for (int ai = 0; ai < 2; ++ai) _Pragma("unroll") for (int m = 0; m < 4; ++m) { const int row = u.pm * 256 + ai * 128 + wr * 64 + m * 16 + fr; \
    _Pragma("unroll") for (int bj = 0; bj < 2; ++bj) { const int col0 = u.pn * 256 + bj * 128 + wc * 32 + 8 * fq; f32x4 v0 = acc[ai][bj][m][0], v1 = acc[ai][bj][m][1];
#define EPI_LOOP_END } }

DI u32x4 pack8(const f32x4& v0, const f32x4& v1) { u32x4 w; w.x = pk2(v0[0], v0[1]); w.y = pk2(v0[2], v0[3]); w.z = pk2(v1[0], v1[1]); w.w = pk2(v1[2], v1[3]); return w; }
DI void rope8(f32x4& v0, f32x4& v1, const float2* tab) {
    const float2 c0 = tab[0], c1 = tab[1], c2 = tab[2], c3 = tab[3];
    float a, b;
    a = v0[0]; b = v0[1]; v0[0] = a * c0.x - b * c0.y; v0[1] = b * c0.x + a * c0.y;
    a = v0[2]; b = v0[3]; v0[2] = a * c1.x - b * c1.y; v0[3] = b * c1.x + a * c1.y;
    a = v1[0]; b = v1[1]; v1[0] = a * c2.x - b * c2.y; v1[1] = b * c2.x + a * c2.y;
    a = v1[2]; b = v1[3]; v1[2] = a * c3.x - b * c3.y; v1[3] = b * c3.x + a * c3.y;
}

struct EpiInProj {
    bf16_t* P; const float2* ropeH; const float2* ropeR; float* ssq_q; float* ssq_kv;
    DI void operator()(const AccT& acc, const Unit& u, int wr, int wc, int fr, int fq) const {
        asm volatile("" : "+v"(fr), "+v"(fq));
        EPI_LOOP_BEGIN
            const int pos = row & (SEQ - 1);
            const bool r64 = (col0 < C_SV) || (col0 >= C_RQ && col0 < C_RV);
            const bool r32 = (col0 >= C_KR && col0 < C_KR + 32);
            if (r64) rope8(v0, v1, ropeH + pos * 32 + ((col0 & 63) >> 1));
            if (r32) rope8(v0, v1, ropeR + pos * 16 + ((col0 - C_KR) >> 1));
            float sc = 1.f;
            if (col0 < C_SK) sc = 0.125f * LOG2E;
            if (col0 >= C_RK && col0 < C_RV) sc = 0.125f;
            v0 = v0 * sc; v1 = v1 * sc;
            if (col0 >= C_CQ && col0 < C_KR) {
                float s = (v0[0] * v0[0] + v0[1] * v0[1]) + (v0[2] * v0[2] + v0[3] * v0[3]) + (v1[0] * v1[0] + v1[1] * v1[1]) + (v1[2] * v1[2] + v1[3] * v1[3]);
                s += __shfl_xor(s, 16); s += __shfl_xor(s, 32);
                if (fq == 0) { if (col0 < C_CKV) ssq_q[row * 8 + bj * 4 + wc] = s; else ssq_kv[row * 4 + wc] = s; }
            }
            if (col0 >= C_U && col0 < C_RQ) { const int ch = col0 - C_U; const int R = (ch >> 4) * 1024 + (row >> 5);
                *(u32x4*)(P + (size_t)R * PP + C_U + (row & 31) * 16 + (ch & 15)) = pack8(v0, v1); }
            else *(u32x4*)(P + (size_t)row * PP + col0) = pack8(v0, v1);
        EPI_LOOP_END
    }
};
struct EpiLE {
    bf16_t* LEb;
    DI void operator()(const AccT& acc, const Unit& u, int wr, int wc, int fr, int fq) const {
        asm volatile("" : "+v"(fr), "+v"(fq));
        EPI_LOOP_BEGIN
            if (bj == 0) *(u32x4*)(LEb + (size_t)row * 128 + (col0 & 127)) = pack8(v0, v1);
        EPI_LOOP_END
    }
};
DI float gelu_tanh(float y) { const float t = 0.7978845608028654f * (y + 0.044715f * y * y * y); const float e = ex2(2.f * LOG2E * t); const float th = 1.f - 2.f * __builtin_amdgcn_rcpf(e + 1.f); return 0.5f * y * (1.f + th); }
struct EpiS5Out {
    bf16_t* P; const float* dskip;
    DI void operator()(const AccT& acc, const Unit& u, int wr, int wc, int fr, int fq) const {
        asm volatile("" : "+v"(fr), "+v"(fq));
        EPI_LOOP_BEGIN
            const int g = row >> 10, cr = row & 1023, t = (col0 & 511) >> 4, c0 = col0 & 15;
            const size_t token = (size_t)(cr >> 7) * SEQ + (size_t)(cr & 127) * 32 + t;
            const u32x4 uv = *(const u32x4*)(P + (size_t)row * PP + C_U + t * 16 + c0);
            const f32x4 d0 = *(const f32x4*)(dskip + 16 * g + c0), d1 = *(const f32x4*)(dskip + 16 * g + c0 + 4);
            v0[0] = gelu_tanh(v0[0] + d0[0] * bflo(uv.x)); v0[1] = gelu_tanh(v0[1] + d0[1] * bfhi(uv.x)); v0[2] = gelu_tanh(v0[2] + d0[2] * bflo(uv.y)); v0[3] = gelu_tanh(v0[3] + d0[3] * bfhi(uv.y));
            v1[0] = gelu_tanh(v1[0] + d1[0] * bflo(uv.z)); v1[1] = gelu_tanh(v1[1] + d1[1] * bfhi(uv.z)); v1[2] = gelu_tanh(v1[2] + d1[2] * bflo(uv.w)); v1[3] = gelu_tanh(v1[3] + d1[3] * bfhi(uv.w));
            const int ch = 16 * g + c0;
            *(u32x4*)(P + token * PP + (ch < 256 ? C_SK + ch : C_CQ + ch - 256)) = pack8(v0, v1);
        EPI_LOOP_END
    }
};
struct EpiQup {
    bf16_t* Qm; const float2* ropeR; const float* ssq_q;
    DI void operator()(const AccT& acc, const Unit& u, int wr, int wc, int fr, int fq) const {
        asm volatile("" : "+v"(fr), "+v"(fq));
        EPI_LOOP_BEGIN
            const f32x4 q0 = *(const f32x4*)(ssq_q + row * 8), q1 = *(const f32x4*)(ssq_q + row * 8 + 4);
            const float sc = rsqrtf((((q0[0] + q0[1]) + (q0[2] + q0[3])) + ((q1[0] + q1[1]) + (q1[2] + q1[3]))) * (1.f / 256.f) + EPS) * (0.10206207261596577f * LOG2E);
            v0 = v0 * sc; v1 = v1 * sc;
            if (col0 >= 512) rope8(v0, v1, ropeR + (row & (SEQ - 1)) * 16 + ((col0 & 31) >> 1));
            *(u32x4*)(Qm + (size_t)row * 768 + col0) = pack8(v0, v1);
        EPI_LOOP_END
    }
};
struct EpiKVup {
    bf16_t* KV; const float* ssq_kv;
    DI void operator()(const AccT& acc, const Unit& u, int wr, int wc, int fr, int fq) const {
        asm volatile("" : "+v"(fr), "+v"(fq));
        EPI_LOOP_BEGIN
            const f32x4 q0 = *(const f32x4*)(ssq_kv + row * 4);
            const float sc = rsqrtf(((q0[0] + q0[1]) + (q0[2] + q0[3])) * (1.f / 128.f) + EPS);
            v0 = v0 * sc; v1 = v1 * sc;
            *(u32x4*)(KV + (size_t)row * 1024 + col0) = pack8(v0, v1);
        EPI_LOOP_END
    }
};
struct EpiGlu {
    bf16_t* P;
    DI void operator()(const AccT& acc, const Unit& u, int wr, int wc, int fr, int fq) const {
        asm volatile("" : "+v"(fr), "+v"(fq));
        EPI_LOOP_BEGIN
            u32x2 w; w.x = pk2(v0[0] * sigmoidf_(v0[1]), v0[2] * sigmoidf_(v0[3])); w.y = pk2(v1[0] * sigmoidf_(v1[1]), v1[2] * sigmoidf_(v1[3]));
            *(u32x2*)(P + (size_t)row * PP + C_RQ + (col0 >> 1)) = w;
        EPI_LOOP_END
    }
};
struct EpiMerge {
    bf16_t* merged; u32x2* scrG;
    DI void operator()(const AccT& acc, const Unit& u, int wr, int wc, int fr, int fq) const {
        asm volatile("" : "+v"(fr), "+v"(fq));
        int tid = my_tid(); asm volatile("" : "+v"(tid));
        if (u.tag < 4) {
            u32x2* sG = scrG + (size_t)u.tag * 16 * 512 + tid;
            EPI_LOOP_BEGIN
                unsigned q[8];
#pragma unroll
                for (int e = 0; e < 4; ++e) { q[e] = (unsigned)(sigmoidf_(v0[e]) * 255.f + 0.5f); q[4 + e] = (unsigned)(sigmoidf_(v1[e]) * 255.f + 0.5f); }
                u32x2 w; w.x = q[0] | (q[1] << 8) | (q[2] << 16) | (q[3] << 24); w.y = q[4] | (q[5] << 8) | (q[6] << 16) | (q[7] << 24);
                *sG = w; sG += 512; asm volatile("" : "+v"(sG)); (void)row; (void)col0;
            EPI_LOOP_END
        } else {
            const int b = u.tag - 4;
            u32x2* sG = scrG + (size_t)b * 16 * 512 + tid;
#pragma unroll
            for (int ai = 0; ai < 2; ++ai) {
                asm volatile("" : "+v"(sG));
                u32x2 gq[8]; u32x4 mpv[8];
#pragma unroll
                for (int q = 0; q < 8; ++q) { const int m = q >> 1, bj = q & 1;
                    const int row = u.pm * 256 + ai * 128 + wr * 64 + m * 16 + fr, col0 = u.pn * 256 + bj * 128 + wc * 32 + 8 * fq;
                    gq[q] = sG[q * 512]; if (b > 0) mpv[q] = *(const u32x4*)(merged + (size_t)row * 1024 + col0); }
#pragma unroll
                for (int q = 0; q < 8; ++q) { const int m = q >> 1, bj = q & 1;
                    const int row = u.pm * 256 + ai * 128 + wr * 64 + m * 16 + fr, col0 = u.pn * 256 + bj * 128 + wc * 32 + 8 * fq;
                    const f32x4 v0 = acc[ai][bj][m][0], v1 = acc[ai][bj][m][1]; const u32x2 g = gq[q]; const float k = 1.f / 255.f; f32x4 p0, p1;
                    p0[0] = v0[0] * ((float)(g.x & 0xffu) * k); p0[1] = v0[1] * ((float)((g.x >> 8) & 0xffu) * k); p0[2] = v0[2] * ((float)((g.x >> 16) & 0xffu) * k); p0[3] = v0[3] * ((float)(g.x >> 24) * k);
                    p1[0] = v1[0] * ((float)(g.y & 0xffu) * k); p1[1] = v1[1] * ((float)((g.y >> 8) & 0xffu) * k); p1[2] = v1[2] * ((float)((g.y >> 16) & 0xffu) * k); p1[3] = v1[3] * ((float)(g.y >> 24) * k);
                    if (b > 0) { const u32x4 mp = mpv[q];
                        p0[0] += bflo(mp.x); p0[1] += bfhi(mp.x); p0[2] += bflo(mp.y); p0[3] += bfhi(mp.y); p1[0] += bflo(mp.z); p1[1] += bfhi(mp.z); p1[2] += bflo(mp.w); p1[3] += bfhi(mp.w); }
                    *(u32x4*)(merged + (size_t)row * 1024 + col0) = pack8(p0, p1); }
                sG += 4096;
            }
        }
    }
};
struct EpiZ {
    bf16_t* Z; float* ssq;
    DI void operator()(const AccT& acc, const Unit& u, int wr, int wc, int fr, int fq) const {
        asm volatile("" : "+v"(fr), "+v"(fq));
#pragma unroll
        for (int ai = 0; ai < 2; ++ai)
#pragma unroll
            for (int m = 0; m < 4; ++m) { const int row = u.pm * 256 + ai * 128 + wr * 64 + m * 16 + fr; float s = 0.f;
#pragma unroll
                for (int bj = 0; bj < 2; ++bj) { const int col0 = u.pn * 256 + bj * 128 + wc * 32 + 8 * fq; const f32x4 v0 = acc[ai][bj][m][0], v1 = acc[ai][bj][m][1];
                    s += (v0[0] * v0[0] + v0[1] * v0[1]) + (v0[2] * v0[2] + v0[3] * v0[3]) + (v1[0] * v1[0] + v1[1] * v1[1]) + (v1[2] * v1[2] + v1[3] * v1[3]);
                    *(u32x4*)(Z + (size_t)row * 1024 + col0) = pack8(v0, v1); }
                s += __shfl_xor(s, 16); s += __shfl_xor(s, 32);
                if (fq == 0) ssq[row * 16 + u.pn * 4 + wc] = s; }
    }
};
struct EpiFF1 {
    bf16_t* H;
    DI void operator()(const AccT& acc, const Unit& u, int wr, int wc, int fr, int fq) const {
        asm volatile("" : "+v"(fr), "+v"(fq));
        EPI_LOOP_BEGIN
#pragma unroll
            for (int e = 0; e < 4; ++e) { float a = fmaxf(v0[e], 0.f); v0[e] = a * a; float c = fmaxf(v1[e], 0.f); v1[e] = c * c; }
            *(u32x4*)(H + ((((size_t)u.pm * 64 + (col0 >> 6)) * 256 + (row & 255)) * 64 + (col0 & 63))) = pack8(v0, v1);
        EPI_LOOP_END
    }
};

struct S5StateSched {
    const char* P; const char* Wst; int G, c;
    DI bool next(int i, Unit& u) const { const int t = (G - 1 - c) + i * G; if (t >= 128) return false;
        u.pm = t; u.pn = 0; u.tag = 0; u.ksA = 128; u.A = P + ((size_t)t * 256 * PP + C_U) * 2; u.ldaB = PP * 2; u.B = Wst + (size_t)(t >> 2) * 128 * 512 * 2; u.kB = 1024; u.nt = 8; return true; }
};
struct S5OutSched {
    const char* P; const char* Xp; const char* Tz; const char* Mc; int G, c;
    DI bool next(int i, Unit& u) const { const int t = c + (i >> 1) * G; if (t >= 256) return false; const int gp = t >> 1, pn = t & 1, g = t >> 3;
        u.pm = gp; u.pn = pn; u.ksA = 128;
        if ((i & 1) == 0) { u.tag = 0x100; u.A = P + ((size_t)gp * 256 * PP + C_U) * 2; u.ldaB = PP * 2; u.B = Tz + (size_t)(g * 512 + pn * 256) * 512 * 2; u.kB = 1024; u.nt = 8; }
        else { u.tag = 0; u.A = Xp + (size_t)gp * 256 * 128 * 2; u.ldaB = 256; u.B = Mc + (size_t)(g * 512 + pn * 256) * 128 * 2; u.kB = 256; u.nt = 2; }
        return true; }
};
struct GluSched {
    const char* P; const char* W; int G, c;
    DI bool next(int i, Unit& u) const { int pm, pn; if (!eng::tile_of(i >> 1, G, c, 128, 4, pm, pn)) return false; const int sub = i & 1;
        u.pm = pm; u.pn = pn; u.ksA = 128; u.tag = sub ? 0 : 0x100; u.A = P + ((size_t)pm * 256 * PP + (sub ? C_CQ : C_SK)) * 2; u.ldaB = PP * 2;
        u.B = W + ((size_t)pn * 256 * 512 + sub * 256) * 2; u.kB = 1024; u.nt = 4; return true; }
};
struct MergeSched {
    const char* XN; const char* Wg; const char* Wb; const char* P; const char* Qm; int G, c;
    DI bool next(int i, Unit& u) const {
        const int ti = i >> 3, sub = i & 7, b = sub & 3; int pm, pn;
        if (!eng::tile_of(ti, G, c, 128, 4, pm, pn)) return false;
        u.pm = pm; u.pn = pn; u.tag = sub; u.ksA = 128;
        if (sub < 4) { u.A = XN + (size_t)pm * 256 * 2048; u.ldaB = 2048; u.kB = 2048; u.nt = 16; u.B = Wg + (size_t)(b * 1024 + pn * 256) * 2048; }
        else { const int ld = (b == 3) ? 768 * 2 : PP * 2; const int coff = (b == 0) ? C_SQ * 2 : (b == 1) ? C_RQ * 2 : (b == 2) ? C_RG * 2 : 0;
            const char* Y = (b == 3) ? Qm : P;
            u.A = Y + coff + (size_t)pm * 256 * ld; u.ldaB = ld; u.kB = 1024; u.nt = 8; u.B = Wb + (size_t)(b * 1024 + pn * 256) * 1024; }
        return true;
    }
};

enum { MAP_IN = 0, MAP_GATE, MAP_GLU, MAP_UQ, MAP_UKV, MAP_ID };
DI int il(int w, int dim) { return (w >> 1) + (dim >> 1) * (w & 1); }
DI int srccol(int kind, int j) {
    switch (kind) {
    case MAP_IN:
        if (j < C_SV) return (j & ~63) + il(j & 63, 64);
        if (j < C_RQ) return j;
        if (j < C_RV) return (j & ~63) + il(j & 63, 64);
        if (j < C_KR) return j;
        if (j < C_KR + 32) return C_KR + il(j - C_KR, 32);
        return -1;
    case MAP_GATE: return 3232 + j;
    case MAP_GLU: return (j >> 1) + 512 * (j & 1);
    case MAP_UQ: if (j < 512) return (j >> 6) * 96 + (j & 63); else { const int jj = j - 512; return (jj >> 5) * 96 + 64 + il(jj & 31, 32); }
    case MAP_UKV: if (j < 512) return (j >> 6) * 128 + (j & 63); else { const int jj = j - 512; return (jj >> 6) * 128 + 64 + (jj & 63); }
    default: return j;
    }
}
DI void conv_item(const float* W, int ldw, int K, int Ndst, int kind, const float* kscale, bf16_t* WT, LAS float* scr, int item, int lane, int ldo = 0) {
    if (ldo == 0) ldo = K;
    const int nblk = Ndst / 32, kb = item / nblk, nb = item % nblk, k0 = 64 * kb, n0 = 32 * nb;
    const int sc = srccol(kind, n0 + (lane & 31));
    float wv[32];
#pragma unroll
    for (int i = 0; i < 32; ++i) { const int kk = 2 * i + (lane >> 5); wv[i] = (sc >= 0) ? W[(size_t)(k0 + kk) * ldw + sc] : 0.f; }
#pragma unroll
    for (int i = 0; i < 32; ++i) { const int kk = 2 * i + (lane >> 5); float v = wv[i]; if (kscale) v *= kscale[k0 + kk]; scr[kk * 33 + (lane & 31)] = v; }
    asm volatile("s_waitcnt lgkmcnt(0)" ::: "memory");
    const int c = lane & 7;
#pragma unroll
    for (int j = 0; j < 4; ++j) { const int n = (lane >> 3) + 8 * j; const LAS float* s = scr + (8 * c) * 33 + n;
        u32x4 o; o.x = pk2(s[0 * 33], s[1 * 33]); o.y = pk2(s[2 * 33], s[3 * 33]); o.z = pk2(s[4 * 33], s[5 * 33]); o.w = pk2(s[6 * 33], s[7 * 33]);
        *(u32x4*)(WT + (size_t)(n0 + n) * ldo + k0 + 8 * c) = o; }
    asm volatile("s_waitcnt lgkmcnt(0)" ::: "memory");
}
DI void prep_weights(const Args& a, int l, LAS unsigned char* lds) {
    int tid = my_tid(); asm volatile("" : "+v"(tid)); const int lane = tid & 63, wave = tid >> 6;
    LAS float* scr = (LAS float*)(lds + wave * 8704);
    unsigned char* ws = a.ws;
    const float* w_in = a.in[5] + (size_t)l * DM * DIN;
    constexpr int I_IN = 16 * 104, I_GATE = 16 * 128, I_GLU = 8 * 32, I_UQ = 4 * 24, I_UKV = 2 * 32, I_BR = 8 * 32, I_OUT = 16 * 32, I_FF1 = 16 * 128, I_FF2 = 64 * 32;
    constexpr int NIT = I_IN + I_GATE + I_GLU + I_UQ + I_UKV + 4 * I_BR + I_OUT + I_FF1 + I_FF2;
    const int gw = blockIdx.x * 8 + wave, NGW = gridDim.x * 8;
    for (int it = gw; it < NIT; it += NGW) {
        int r = it;
        if (r < I_IN) { conv_item(w_in, DIN, 1024, 3328, MAP_IN, nullptr, (bf16_t*)(ws + W_IN), scr, r, lane); continue; } r -= I_IN;
        if (r < I_GATE) { conv_item(w_in, DIN, 1024, 4096, MAP_GATE, nullptr, (bf16_t*)(ws + W_GATE), scr, r, lane); continue; } r -= I_GATE;
        if (r < I_GLU) { conv_item(a.in[15] + (size_t)l * 512 * 1024, 1024, 512, 1024, MAP_GLU, nullptr, (bf16_t*)(ws + W_GLU), scr, r, lane); continue; } r -= I_GLU;
        if (r < I_UQ) { conv_item(a.in[18] + (size_t)l * 256 * 768, 768, 256, 768, MAP_UQ, a.in[16] + l * 256, (bf16_t*)(ws + W_UQ), scr, r, lane); continue; } r -= I_UQ;
        if (r < I_UKV) { conv_item(a.in[19] + (size_t)l * 128 * 1024, 1024, 128, 1024, MAP_UKV, a.in[17] + l * 128, (bf16_t*)(ws + W_UKV), scr, r, lane); continue; } r -= I_UKV;
        if (r < 4 * I_BR) { const int b = r / I_BR; conv_item(a.in[20] + ((size_t)l * 4 + b) * 512 * 1024, 1024, 512, 1024, MAP_ID, nullptr, (bf16_t*)(ws + W_BR) + (size_t)b * 1024 * 512, scr, r % I_BR, lane); continue; } r -= 4 * I_BR;
        if (r < I_OUT) { conv_item(a.in[21] + (size_t)l * 1024 * 1024, 1024, 1024, 1024, MAP_ID, nullptr, (bf16_t*)(ws + W_OUT), scr, r, lane); continue; } r -= I_OUT;
        if (r < I_FF1) { conv_item(a.in[22] + (size_t)l * 1024 * 4096, 4096, 1024, 4096, MAP_ID, nullptr, (bf16_t*)(ws + W_FF1), scr, r, lane); continue; } r -= I_FF1;
        conv_item(a.in[23] + (size_t)l * 4096 * 1024, 1024, 4096, 1024, MAP_ID, nullptr, (bf16_t*)(ws + W_FF2), scr, r, lane, HP);
    }
}

DI void s5_tables(const Args& a, int l, LAS unsigned char* lds) {
    LAS float* are = (LAS float*)lds;
    LAS float* aim = are + 33 * 64;
    LAS float* bbr = aim + 33 * 64;
    LAS float* bbi = bbr + 1024;
    LAS float* cre = bbi + 1024;
    LAS float* cim = cre + 1024;
    LAS float* ktab = cim + 1024;
    int tid = my_tid(); asm volatile("" : "+v"(tid));
    unsigned char* ws = a.ws;
    for (int un = blockIdx.x; un < 256; un += gridDim.x) {
        const int g = un >> 3, j4 = (un & 7) * 4;
        __syncthreads();
        const float* lam_re = a.in[7] + ((size_t)l * 32 + g) * 64; const float* lam_im = a.in[8] + ((size_t)l * 32 + g) * 64;
        const float dt = expf(a.in[9][l * 32 + g]);
        const float* b_re = a.in[10] + ((size_t)l * 32 + g) * 1024; const float* b_im = a.in[11] + ((size_t)l * 32 + g) * 1024;
        const float* c_re = a.in[12] + ((size_t)l * 32 + g) * 1024; const float* c_im = a.in[13] + ((size_t)l * 32 + g) * 1024;
        for (int e = tid; e < 33 * 64; e += 512) { const int tau = e >> 6, p = e & 63; const float mag = expf(lam_re[p] * dt * (float)tau); float sn, cs; sincosf(lam_im[p] * dt * (float)tau, &sn, &cs); are[e] = mag * cs; aim[e] = mag * sn; }
        for (int e = tid; e < 1024; e += 512) { const int p = e >> 4; const float lr = lam_re[p], li = lam_im[p]; const float mag = expf(lr * dt); float sn, cs; sincosf(li * dt, &sn, &cs);
            const float nr = mag * cs - 1.f, ni = mag * sn, den = lr * lr + li * li; const float fr_ = (nr * lr + ni * li) / den, fi_ = (ni * lr - nr * li) / den;
            const float br = b_re[e], bi = b_im[e]; bbr[e] = fr_ * br - fi_ * bi; bbi[e] = fr_ * bi + fi_ * br;
            cre[e] = c_re[e]; cim[e] = c_im[e]; }
        __syncthreads();
        for (int e = tid; e < 4 * 256; e += 512) { const int tau = j4 + (e >> 8), c = (e >> 4) & 15, c2 = e & 15; float s = 0.f;
            for (int p = 0; p < 64; ++p) { const float cr = cre[c * 64 + p], ci = cim[c * 64 + p], ar = are[tau * 64 + p], ai = aim[tau * 64 + p];
                const float car = cr * ar - ci * ai, cai = cr * ai + ci * ar; s += car * bbr[p * 16 + c2] - cai * bbi[p * 16 + c2]; }
            ktab[e] = s; }
        __syncthreads();
        bf16_t* Tz = (bf16_t*)(ws + OFF_TZ) + (size_t)g * 512 * 512;
        for (int e = tid; e < 4 * 32 * 32; e += 512) { const int tq = e >> 10, t = (e >> 5) & 31, c = (e >> 1) & 15, hf = e & 1; const int tau = j4 + tq, sx = t - tau;
            if (sx >= 0) { const LAS float* kp = ktab + tq * 256 + c * 16 + hf * 8; u32x4 o; o.x = pk2(kp[0], kp[1]); o.y = pk2(kp[2], kp[3]); o.z = pk2(kp[4], kp[5]); o.w = pk2(kp[6], kp[7]);
                *(u32x4*)(Tz + (size_t)(t * 16 + c) * 512 + sx * 16 + hf * 8) = o; } }
        for (int e = tid; e < 4 * 16 * 64; e += 512) { const int t = j4 + (e >> 10), c = (e >> 6) & 15, k0 = (e & 63) * 8;
            if ((k0 >> 4) > t) *(u32x4*)(Tz + (size_t)(t * 16 + c) * 512 + k0) = (u32x4){0u, 0u, 0u, 0u}; }
        bf16_t* Mc = (bf16_t*)(ws + OFF_MC) + (size_t)g * 512 * 128;
        for (int e = tid; e < 64 * 128; e += 512) { const int n = j4 * 16 + (e >> 7), pp = e & 127, p = pp & 63, t = n >> 4, c = n & 15;
            const float cr = cre[c * 64 + p], ci = cim[c * 64 + p], ar = are[(t + 1) * 64 + p], ai = aim[(t + 1) * 64 + p];
            const float v = (pp < 64) ? (cr * ar - ci * ai) : -(cr * ai + ci * ar); Mc[(size_t)n * 128 + pp] = (bf16_t)f2bf(v); }
        bf16_t* Wst = (bf16_t*)(ws + OFF_WST) + (size_t)g * 128 * 512;
        for (int e = tid; e < 128 * 64; e += 512) { const int pp = e >> 6, k = j4 * 16 + (e & 63), p = pp & 63, sx = k >> 4, c2 = k & 15;
            const float ar = are[(31 - sx) * 64 + p], ai = aim[(31 - sx) * 64 + p], br = bbr[p * 16 + c2], bi = bbi[p * 16 + c2];
            const float v = (pp < 64) ? (ar * br - ai * bi) : (ar * bi + ai * br); Wst[(size_t)pp * 512 + k] = (bf16_t)f2bf(v); }
        float* aT = (float*)(ws + OFF_AT) + g * 128;
        if (j4 == 0 && tid < 128) aT[tid] = (tid < 64) ? are[32 * 64 + tid] : aim[32 * 64 + tid - 64];
    }
}

DI void norm_rows_first(const float* x, const float* g, bf16_t* XN) {
    int tid = my_tid(); asm volatile("" : "+v"(tid)); const int lane = tid & 63; const int gw = blockIdx.x * 8 + (tid >> 6), NGW = gridDim.x * 8;
    for (int m0 = 2 * gw; m0 < M; m0 += 2 * NGW) {
        f32x4 v[2][4];
#pragma unroll
        for (int q = 0; q < 2; ++q) { const f32x4* xr = (const f32x4*)(x + (size_t)(m0 + q) * DM) + lane;
#pragma unroll
            for (int j = 0; j < 4; ++j) v[q][j] = xr[64 * j]; }
#pragma unroll
        for (int q = 0; q < 2; ++q) { float s = 0.f;
#pragma unroll
            for (int j = 0; j < 4; ++j) s += (v[q][j].x * v[q][j].x + v[q][j].y * v[q][j].y) + (v[q][j].z * v[q][j].z + v[q][j].w * v[q][j].w);
            const float rstd = rsqrtf(wave_sum(s) * (1.f / DM) + EPS);
            u32x2* o = (u32x2*)(XN + (size_t)(m0 + q) * DM) + lane;
#pragma unroll
            for (int j = 0; j < 4; ++j) { const f32x4 gg = ((const f32x4*)g)[lane + 64 * j]; u32x2 w; w.x = pk2(v[q][j].x * rstd * gg.x, v[q][j].y * rstd * gg.y); w.y = pk2(v[q][j].z * rstd * gg.z, v[q][j].w * rstd * gg.w); o[64 * j] = w; } }
    }
}
template <bool XIN, bool XOUT>
DI void norm_rows_res(const void* xsrc, const bf16_t* Z, const float* ssq, const float* gpost, void* out, const float* gpre, bf16_t* XN) {
    int tid = my_tid(); asm volatile("" : "+v"(tid)); const int lane = tid & 63; const int gw = blockIdx.x * 8 + (tid >> 6), NGW = gridDim.x * 8;
    for (int m0 = 4 * gw; m0 < M; m0 += 4 * NGW) {
        f32x4 xv[4][4]; u32x2 zw[4][4]; float sq[4];
#pragma unroll
        for (int q = 0; q < 4; ++q) { const int m = m0 + q; const u32x2* zr = (const u32x2*)(Z + (size_t)m * DM) + lane;
            sq[q] = ssq[(size_t)m * 16 + (lane & 15)];
#pragma unroll
            for (int j = 0; j < 4; ++j) { zw[q][j] = zr[64 * j];
                if (XIN) { const u32x2 xw = ((const u32x2*)((const bf16_t*)xsrc + (size_t)m * DM) + lane)[64 * j]; xv[q][j] = (f32x4){bflo(xw.x), bfhi(xw.x), bflo(xw.y), bfhi(xw.y)}; }
                else xv[q][j] = ((const f32x4*)((const float*)xsrc + (size_t)m * DM) + lane)[64 * j]; } }
#pragma unroll
        for (int q = 0; q < 4; ++q) { const int m = m0 + q;
            float s2 = sq[q]; s2 += __shfl_xor(s2, 1); s2 += __shfl_xor(s2, 2); s2 += __shfl_xor(s2, 4); s2 += __shfl_xor(s2, 8);
            const float rz = rsqrtf(s2 * (1.f / DM) + EPS);
            f32x4 v[4]; float s = 0.f;
#pragma unroll
            for (int j = 0; j < 4; ++j) { const f32x4 gp = ((const f32x4*)gpost)[lane + 64 * j]; const f32x4 x4 = xv[q][j]; const u32x2 z2 = zw[q][j];
                v[j].x = x4.x + bflo(z2.x) * rz * gp.x; v[j].y = x4.y + bfhi(z2.x) * rz * gp.y; v[j].z = x4.z + bflo(z2.y) * rz * gp.z; v[j].w = x4.w + bfhi(z2.y) * rz * gp.w;
                s += (v[j].x * v[j].x + v[j].y * v[j].y) + (v[j].z * v[j].z + v[j].w * v[j].w); }
#pragma unroll
            for (int j = 0; j < 4; ++j) {
                if (XOUT) { u32x2 w; w.x = pk2(v[j].x, v[j].y); w.y = pk2(v[j].z, v[j].w); ((u32x2*)((bf16_t*)out + (size_t)m * DM) + lane)[64 * j] = w; }
                else ((f32x4*)((float*)out + (size_t)m * DM) + lane)[64 * j] = v[j]; }
            if (gpre) { const float rstd = rsqrtf(wave_sum(s) * (1.f / DM) + EPS); u32x2* o = (u32x2*)(XN + (size_t)m * DM) + lane;
#pragma unroll
                for (int j = 0; j < 4; ++j) { const f32x4 gg = ((const f32x4*)gpre)[lane + 64 * j]; u32x2 w; w.x = pk2(v[j].x * rstd * gg.x, v[j].y * rstd * gg.y); w.y = pk2(v[j].z * rstd * gg.z, v[j].w * rstd * gg.w); o[64 * j] = w; } }
        }
    }
}

template <int MODE>
DI void attn_unit(LAS unsigned char* lds, int b, int hd, int qb, bf16_t* P, bf16_t* Qm, const bf16_t* KV, float sink_l2) {
    constexpr int NS = MODE == 0 ? 6 : 4, NC = MODE == 0 ? 12 : 8, KSTR = MODE == 0 ? 208 : 144, VSTR = 272, NKC = MODE == 0 ? 3 : 2, BUFB = 45056;
    int tid = my_tid(); asm volatile("" : "+v"(tid)); const int lane = tid & 63, r = lane & 31, h = lane >> 5, wid = __builtin_amdgcn_readfirstlane(tid >> 6);
    LAS unsigned char* Ks0 = lds; LAS unsigned char* Vt0 = lds + 128 * 208; LAS float* wsf = (LAS float*)(lds + 2 * BUFB) + wid * 32;
    const int q0 = qb * 256; const size_t rowbase = (size_t)b * SEQ; const int kvh = hd >> 2;
    const size_t qrow = rowbase + q0 + wid * 32 + r;
    bf16x8 qf[NS];
#pragma unroll
    for (int s = 0; s < NS; ++s) {
        if (MODE == 0) qf[s] = (s < 4) ? *(const bf16x8*)(Qm + qrow * 768 + hd * 64 + 16 * s + 8 * h) : *(const bf16x8*)(Qm + qrow * 768 + 512 + hd * 32 + 16 * (s - 4) + 8 * h);
        else qf[s] = *(const bf16x8*)(P + qrow * PP + C_SQ + hd * 64 + 16 * s + 8 * h);
    }
    const int kt0 = (MODE == 1 && q0 >= 128) ? (q0 - 128) / 64 : 0, kt1 = (q0 + 255) / 64;
    float mrun = (MODE == 0) ? -1e30f : sink_l2, lrun = (MODE == 1 && h == 0) ? 1.f : 0.f;
    f32x16 O[2];
#pragma unroll
    for (int i = 0; i < 16; ++i) { O[0][i] = 0.f; O[1][i] = 0.f; }
    u32x4 kr[NKC], vr[2];
    auto ksrc = [&](int ci, int kp) -> const bf16_t* { const int row = ci / NC, c = ci % NC; const size_t gr = rowbase + (size_t)kp * 64 + row;
        if (MODE == 0) return (c < 8) ? KV + gr * 1024 + hd * 64 + 8 * c : P + gr * PP + C_KR + 8 * (c - 8);
        else return P + gr * PP + C_SK + kvh * 64 + 8 * c; };
    auto vsrc = [&](int ci, int kp) -> const bf16_t* { const int vrow = ci & 127, vc = ci >> 7; const size_t gr = rowbase + (size_t)kp * 64 + vrow;
        if (MODE == 0) return KV + gr * 1024 + 512 + hd * 64 + 8 * vc; else return P + gr * PP + C_SV + kvh * 64 + 8 * vc; };
#pragma unroll
    for (int j = 0; j < NKC; ++j) kr[j] = *(const u32x4*)ksrc(tid + 512 * j, kt0);
#pragma unroll
    for (int j = 0; j < 2; ++j) vr[j] = *(const u32x4*)vsrc(tid + 512 * j, kt0);
    const int wq_lo = q0 + wid * 32, wq_hi = wq_lo + 31;
    __syncthreads();
    for (int kp = kt0; kp <= kt1; kp += 2) {
        LAS unsigned char* Ks = Ks0 + (((kp - kt0) >> 1) & 1) * BUFB; LAS unsigned char* Vt = Vt0 + (((kp - kt0) >> 1) & 1) * BUFB;
#pragma unroll
        for (int j = 0; j < NKC; ++j) { const int ci = tid + 512 * j; *(LAS u32x4*)(Ks + (ci / NC) * KSTR + (ci % NC) * 16) = kr[j]; }
#pragma unroll
        for (int j = 0; j < 2; ++j) { const int ci = tid + 512 * j, vrow = ci & 127, vc = ci >> 7; const u32x4 v = vr[j]; LAS unsigned char* vb = Vt + (8 * vc) * VSTR + vpos(vrow) * 2;
          *(LAS bf16_t*)(vb + 0 * VSTR) = (bf16_t)(v.x & 0xffff); *(LAS bf16_t*)(vb + 1 * VSTR) = (bf16_t)(v.x >> 16);
          *(LAS bf16_t*)(vb + 2 * VSTR) = (bf16_t)(v.y & 0xffff); *(LAS bf16_t*)(vb + 3 * VSTR) = (bf16_t)(v.y >> 16);
          *(LAS bf16_t*)(vb + 4 * VSTR) = (bf16_t)(v.z & 0xffff); *(LAS bf16_t*)(vb + 5 * VSTR) = (bf16_t)(v.z >> 16);
          *(LAS bf16_t*)(vb + 6 * VSTR) = (bf16_t)(v.w & 0xffff); *(LAS bf16_t*)(vb + 7 * VSTR) = (bf16_t)(v.w >> 16); }
        __syncthreads();
        if (kp + 2 <= kt1) {
#pragma unroll
            for (int j = 0; j < NKC; ++j) kr[j] = *(const u32x4*)ksrc(tid + 512 * j, kp + 2);
#pragma unroll
            for (int j = 0; j < 2; ++j) vr[j] = *(const u32x4*)vsrc(tid + 512 * j, kp + 2);
        }
        {
        const int kv_lo = kp * 64;
        const bool skip = (kv_lo > wq_hi) || (MODE == 1 && kv_lo + 127 < wq_lo - 127);
        if (!skip) {
            f32x16 p[4];
#pragma unroll
            for (int t = 0; t < 4; ++t)
#pragma unroll
                for (int i = 0; i < 16; ++i) p[t][i] = 0.f;
#pragma unroll
            for (int s = 0; s < NS; ++s)
#pragma unroll
                for (int t = 0; t < 4; ++t) { const bf16x8 a0 = *(const LAS bf16x8*)(Ks + (32 * t + r) * KSTR + (16 * s + 8 * h) * 2); p[t] = MFMA32(a0, qf[s], p[t]); }
            const int qa = wq_lo + r;
            const bool need_mask = (MODE == 0) ? (kv_lo + 127 > wq_lo) : ((kv_lo + 127 > wq_lo) || (wq_hi - kv_lo >= 128));
            if (need_mask) {
#pragma unroll
                for (int t = 0; t < 4; ++t)
#pragma unroll
                    for (int i = 0; i < 16; ++i) { const int d0 = qa - (kv_lo + 32 * t + crow(i, h)); const bool ok = (MODE == 0) ? (d0 >= 0) : (d0 >= 0 && d0 < 128); p[t][i] = ok ? p[t][i] : -1e30f; }
            }
            float tmax = fmaxf(fmaxf(p[0][0], p[1][0]), fmaxf(p[2][0], p[3][0]));
#pragma unroll
            for (int i = 1; i < 16; ++i) tmax = fmaxf(fmaxf(fmaxf(tmax, p[0][i]), fmaxf(p[1][i], p[2][i])), p[3][i]);
            tmax = fmaxf(tmax, __shfl_xor(tmax, 32));
            const float mn = fmaxf(mrun, tmax), alpha = ex2(mrun - mn); mrun = mn;
            float ls = 0.f;
#pragma unroll
            for (int t = 0; t < 4; ++t)
#pragma unroll
                for (int i = 0; i < 16; ++i) { p[t][i] = ex2(p[t][i] - mn); ls += p[t][i]; }
            lrun = lrun * alpha + ls;
            if (__builtin_amdgcn_ballot_w64(alpha < 1.f) != 0ull) {
                if (h == 0) wsf[r] = alpha;
                __builtin_amdgcn_wave_barrier();
#pragma unroll
                for (int i = 0; i < 16; ++i) { const float af = wsf[crow(i, h)]; O[0][i] *= af; O[1][i] *= af; }
                __builtin_amdgcn_wave_barrier();
            }
#pragma unroll
            for (int s2 = 0; s2 < 8; ++s2) {
                const bf16x8 pa = packp(p[s2 >> 1], 8 * (s2 & 1));
#pragma unroll
                for (int dh = 0; dh < 2; ++dh) { const bf16x8 vb = *(const LAS bf16x8*)(Vt + (dh * 32 + r) * VSTR + (16 * s2 + 8 * h) * 2); O[dh] = MFMA32(pa, vb, O[dh]); }
            }
        }
        }
    }
    const float lt = lrun + __shfl_xor(lrun, 32);
    if (h == 0) wsf[r] = 1.f / lt;
    __builtin_amdgcn_wave_barrier();
#pragma unroll
    for (int i = 0; i < 16; ++i) { const float inv = wsf[crow(i, h)]; const size_t orow = rowbase + q0 + wid * 32 + crow(i, h);
#pragma unroll
        for (int dh = 0; dh < 2; ++dh) { const bf16_t o = (bf16_t)f2bf(O[dh][i] * inv);
            if (MODE == 0) Qm[orow * 768 + hd * 64 + dh * 32 + r] = o; else P[orow * PP + C_SQ + hd * 64 + dh * 32 + r] = o; } }
    __builtin_amdgcn_wave_barrier();
}

DI float ret_log2g(int hd) { return log2f(1.f - ex2(-5.f - (float)hd)); }
DI void ret_state_unit(LAS unsigned char* lds, const bf16_t* P, bf16_t* RS, int u) {
    const int b = u >> 7, n = (u >> 2) & 31, hd = u & 3;
    int tid = my_tid(); asm volatile("" : "+v"(tid)); const int lane = tid & 63, r = lane & 31, h = lane >> 5, wid = __builtin_amdgcn_readfirstlane(tid >> 6);
    LAS unsigned char* Kt = lds; LAS unsigned char* Vt = lds + 64 * 272;
    const size_t tok0 = (size_t)b * SEQ + n * 128; const float l2g = ret_log2g(hd);
    __syncthreads();
#pragma unroll
    for (int j = 0; j < 2; ++j) { const int ci = tid + 512 * j, row = ci & 127, c = ci >> 7; const u32x4 v = *(const u32x4*)(P + (tok0 + row) * PP + C_RK + hd * 64 + 8 * c);
        const float kw = ex2(l2g * (float)(127 - row)); LAS unsigned char* d = Kt + (8 * c) * 272 + row * 2;
        *(LAS bf16_t*)(d + 0 * 272) = (bf16_t)f2bf(bflo(v.x) * kw); *(LAS bf16_t*)(d + 1 * 272) = (bf16_t)f2bf(bfhi(v.x) * kw);
        *(LAS bf16_t*)(d + 2 * 272) = (bf16_t)f2bf(bflo(v.y) * kw); *(LAS bf16_t*)(d + 3 * 272) = (bf16_t)f2bf(bfhi(v.y) * kw);
        *(LAS bf16_t*)(d + 4 * 272) = (bf16_t)f2bf(bflo(v.z) * kw); *(LAS bf16_t*)(d + 5 * 272) = (bf16_t)f2bf(bfhi(v.z) * kw);
        *(LAS bf16_t*)(d + 6 * 272) = (bf16_t)f2bf(bflo(v.w) * kw); *(LAS bf16_t*)(d + 7 * 272) = (bf16_t)f2bf(bfhi(v.w) * kw); }
#pragma unroll
    for (int j = 0; j < 4; ++j) { const int ci = tid + 512 * j, row = ci & 127, c = ci >> 7; const u32x4 v = *(const u32x4*)(P + (tok0 + row) * PP + C_RV + hd * 128 + 8 * c);
        LAS unsigned char* d = Vt + (8 * c) * 272 + row * 2;
        *(LAS bf16_t*)(d + 0 * 272) = (bf16_t)(v.x & 0xffff); *(LAS bf16_t*)(d + 1 * 272) = (bf16_t)(v.x >> 16);
        *(LAS bf16_t*)(d + 2 * 272) = (bf16_t)(v.y & 0xffff); *(LAS bf16_t*)(d + 3 * 272) = (bf16_t)(v.y >> 16);
        *(LAS bf16_t*)(d + 4 * 272) = (bf16_t)(v.z & 0xffff); *(LAS bf16_t*)(d + 5 * 272) = (bf16_t)(v.z >> 16);
        *(LAS bf16_t*)(d + 6 * 272) = (bf16_t)(v.w & 0xffff); *(LAS bf16_t*)(d + 7 * 272) = (bf16_t)(v.w >> 16); }
    __syncthreads();
    const int dkh = wid & 1, dvq = wid >> 1;
    f32x16 acc;
#pragma unroll
    for (int i = 0; i < 16; ++i) acc[i] = 0.f;
#pragma unroll
    for (int s = 0; s < 8; ++s) { const bf16x8 af = *(const LAS bf16x8*)(Kt + (32 * dkh + r) * 272 + (16 * s + 8 * h) * 2); const bf16x8 bfr = *(const LAS bf16x8*)(Vt + (32 * dvq + r) * 272 + (16 * s + 8 * h) * 2); acc = MFMA32(bfr, af, acc); }
    bf16_t* o = RS + ((size_t)((b * 32 + n) * 4 + hd)) * 8192;
#pragma unroll
    for (int i = 0; i < 16; ++i) o[(32 * dvq + crow(i, h)) * 64 + 32 * dkh + r] = (bf16_t)f2bf(acc[i]);
}
DI void ret_out_unit(LAS unsigned char* lds, bf16_t* P, const bf16_t* PV, int u) {
    const int b = u >> 7, n = (u >> 2) & 31, hd = u & 3;
    int tid = my_tid(); asm volatile("" : "+v"(tid)); const int lane = tid & 63, r = lane & 31, h = lane >> 5, wid = __builtin_amdgcn_readfirstlane(tid >> 6);
    LAS unsigned char* Ks = lds; LAS unsigned char* Vt = lds + 18432; LAS unsigned char* PvT = lds + 18432 + 34816; LAS float* Y = (LAS float*)lds;
    const size_t tok0 = (size_t)b * SEQ + n * 128; const float l2g = ret_log2g(hd);
    __syncthreads();
    {
        const bf16_t* pv = PV + ((size_t)((b * 32 + n) * 4 + hd)) * 8192;
#pragma unroll
        for (int j = 0; j < 2; ++j) { const int ci = tid + 512 * j, dv = ci >> 3, c = ci & 7; *(LAS u32x4*)(PvT + dv * 144 + c * 16) = *(const u32x4*)(pv + dv * 64 + c * 8); }
    }
#pragma unroll
    for (int j = 0; j < 2; ++j) { const int ci = tid + 512 * j, row = ci >> 3, c = ci & 7; *(LAS u32x4*)(Ks + row * 144 + c * 16) = *(const u32x4*)(P + (tok0 + row) * PP + C_RK + hd * 64 + 8 * c); }
#pragma unroll
    for (int j = 0; j < 4; ++j) { const int ci = tid + 512 * j, row = ci & 127, c = ci >> 7; const u32x4 v = *(const u32x4*)(P + (tok0 + row) * PP + C_RV + hd * 128 + 8 * c);
        LAS unsigned char* d = Vt + (8 * c) * 272 + vpos(row) * 2;
        *(LAS bf16_t*)(d + 0 * 272) = (bf16_t)(v.x & 0xffff); *(LAS bf16_t*)(d + 1 * 272) = (bf16_t)(v.x >> 16);
        *(LAS bf16_t*)(d + 2 * 272) = (bf16_t)(v.y & 0xffff); *(LAS bf16_t*)(d + 3 * 272) = (bf16_t)(v.y >> 16);
        *(LAS bf16_t*)(d + 4 * 272) = (bf16_t)(v.z & 0xffff); *(LAS bf16_t*)(d + 5 * 272) = (bf16_t)(v.z >> 16);
        *(LAS bf16_t*)(d + 6 * 272) = (bf16_t)(v.w & 0xffff); *(LAS bf16_t*)(d + 7 * 272) = (bf16_t)(v.w >> 16); }
    const int wq = wid & 3, wd = wid >> 2;
    bf16x8 qf[4];
#pragma unroll
    for (int s = 0; s < 4; ++s) qf[s] = *(const bf16x8*)(P + (tok0 + 32 * wq + r) * PP + C_RQ + hd * 64 + 16 * s + 8 * h);
    __syncthreads();
    f32x16 O[2], Oc[2];
#pragma unroll
    for (int i = 0; i < 16; ++i) { O[0][i] = 0.f; O[1][i] = 0.f; Oc[0][i] = 0.f; Oc[1][i] = 0.f; }
    for (int kb = 0; kb <= wq; ++kb) {
        f32x16 p;
#pragma unroll
        for (int i = 0; i < 16; ++i) p[i] = 0.f;
#pragma unroll
        for (int s = 0; s < 4; ++s) { const bf16x8 a = *(const LAS bf16x8*)(Ks + (32 * kb + r) * 144 + (16 * s + 8 * h) * 2); p = MFMA32(a, qf[s], p); }
        const int qi = 32 * wq + r;
#pragma unroll
        for (int i = 0; i < 16; ++i) { const int d = qi - (32 * kb + crow(i, h)); p[i] = (d >= 0) ? p[i] * ex2(l2g * (float)d) : 0.f; }
#pragma unroll
        for (int s2 = 0; s2 < 2; ++s2) { const bf16x8 pa = packp(p, 8 * s2);
#pragma unroll
            for (int dh = 0; dh < 2; ++dh) { const bf16x8 vb = *(const LAS bf16x8*)(Vt + (64 * wd + 32 * dh + r) * 272 + (32 * kb + 16 * s2 + 8 * h) * 2); O[dh] = MFMA32(pa, vb, O[dh]); } }
    }
#pragma unroll
    for (int s = 0; s < 4; ++s)
#pragma unroll
        for (int dh = 0; dh < 2; ++dh) { const bf16x8 pb = *(const LAS bf16x8*)(PvT + (64 * wd + 32 * dh + r) * 144 + (16 * s + 8 * h) * 2); Oc[dh] = MFMA32(qf[s], pb, Oc[dh]); }
    __syncthreads();
#pragma unroll
    for (int i = 0; i < 16; ++i) { const int q = 32 * wq + crow(i, h); const float qw = ex2(l2g * (float)(q + 1));
#pragma unroll
        for (int dh = 0; dh < 2; ++dh) Y[q * 132 + 64 * wd + 32 * dh + r] = O[dh][i] + qw * Oc[dh][i]; }
    __syncthreads();
    {
        const int q = tid >> 2, part = tid & 3; const LAS float* yr = Y + q * 132 + part * 32;
        float s = 0.f;
#pragma unroll
        for (int j = 0; j < 32; ++j) s += yr[j];
        s += __shfl_xor(s, 1); s += __shfl_xor(s, 2);
        const float mu = s * (1.f / 128.f); float vs = 0.f;
#pragma unroll
        for (int j = 0; j < 32; ++j) { const float d = yr[j] - mu; vs += d * d; }
        vs += __shfl_xor(vs, 1); vs += __shfl_xor(vs, 2);
        const float rstd = rsqrtf(vs * (1.f / 128.f) + EPS);
        bf16_t* gp = P + (tok0 + q) * PP + C_RG + hd * 128 + part * 32;
#pragma unroll
        for (int c = 0; c < 4; ++c) { const u32x4 gv = *(const u32x4*)(gp + 8 * c); const unsigned gw[4] = {gv.x, gv.y, gv.z, gv.w}; u32x4 o; unsigned ow[4];
#pragma unroll
            for (int e = 0; e < 4; ++e) { const float g0 = bflo(gw[e]), g1 = bfhi(gw[e]); const float y0 = (yr[8 * c + 2 * e] - mu) * rstd, y1 = (yr[8 * c + 2 * e + 1] - mu) * rstd;
                ow[e] = pk2(g0 * sigmoidf_(g0) * y0, g1 * sigmoidf_(g1) * y1); }
            o.x = ow[0]; o.y = ow[1]; o.z = ow[2]; o.w = ow[3]; *(u32x4*)(gp + 8 * c) = o; }
    }
}

DI void s5_scan(const bf16_t* LEb, bf16_t* Xp, const float* aTall, int pair, int lane) {
    const int b = pair >> 5, g = pair & 31; const float* aT = aTall + g * 128;
    const float ar = aT[lane], ai = aT[64 + lane]; float xr = 0.f, xi = 0.f;
    const size_t R0 = (size_t)g * 1024 + (size_t)b * 128;
    for (int n0 = 0; n0 < 128; n0 += 8) {
        float lr[8], li[8];
#pragma unroll
        for (int j = 0; j < 8; ++j) { lr[j] = bf2f(LEb[(R0 + n0 + j) * 128 + lane]); li[j] = bf2f(LEb[(R0 + n0 + j) * 128 + 64 + lane]); }
#pragma unroll
        for (int j = 0; j < 8; ++j) { Xp[(R0 + n0 + j) * 128 + lane] = (bf16_t)f2bf(xr); Xp[(R0 + n0 + j) * 128 + 64 + lane] = (bf16_t)f2bf(xi);
            const float nr = ar * xr - ai * xi + lr[j], ni = ar * xi + ai * xr + li[j]; xr = nr; xi = ni; }
    }
}
DI void ret_prefix(const bf16_t* RS, bf16_t* PV, int tt) {
    const int bh = tt >> 12, pr = tt & 4095, b = bh >> 2, hd = bh & 3;
    const float cd = ex2(ret_log2g(hd) * 128.f);
    const unsigned* src = (const unsigned*)RS + ((size_t)(b * 32) * 4 + hd) * 4096 + pr; unsigned* dst = (unsigned*)PV + ((size_t)(b * 32) * 4 + hd) * 4096 + pr;
    float s0 = 0.f, s1 = 0.f;
    for (int n0 = 0; n0 < 32; n0 += 8) {
        unsigned w[8];
#pragma unroll
        for (int j = 0; j < 8; ++j) w[j] = src[(size_t)(n0 + j) * 4 * 4096];
#pragma unroll
        for (int j = 0; j < 8; ++j) { dst[(size_t)(n0 + j) * 4 * 4096] = pk2(s0, s1); s0 = s0 * cd + bflo(w[j]); s1 = s1 * cd + bfhi(w[j]); }
    }
}

#define XB_TMO      128
#define XB_XCNT(j)  (256  + 64 * (j))
#define XB_XSUB(j)  (1280 + 64 * (j))
#define XB_XGEN(j)  (2304 + 64 * (j))
#define XB_TOP      3328
#define XB_TOPGEN   3392
#define XCD_BAR_WORDS 3456
#define XB_SPIN_CAP (1u << 20)
DI unsigned xb_ld(unsigned* p)              { return __hip_atomic_load(p, __ATOMIC_RELAXED, __HIP_MEMORY_SCOPE_AGENT); }
DI unsigned xb_add(unsigned* p, unsigned v) { return __hip_atomic_fetch_add(p, v, __ATOMIC_RELAXED, __HIP_MEMORY_SCOPE_AGENT); }
DI unsigned xb_xcc_id() { return (unsigned)__builtin_amdgcn_s_getreg((3 << 11) | 20) & 0xFu; }
#define XB_SPIN(cond, bar) do { unsigned _sp = 0; while (cond) { __builtin_amdgcn_s_sleep(1); \
    if ((++_sp & 255u) == 0u) { if (xb_ld(&(bar)[XB_TMO])) break; if (_sp > XB_SPIN_CAP) { atomicAdd(&(bar)[XB_TMO], 1u); break; } } } } while (0)
struct XcdBarrier { unsigned* bar; unsigned x; volatile LAS unsigned* st; };
DI XcdBarrier xcd_barrier_post(unsigned* bar, volatile LAS unsigned* st) {
    XcdBarrier b; b.bar = bar; b.x = xb_xcc_id(); b.st = st;
    if (my_tid() == 0) (void)xb_add(&bar[XB_XCNT(b.x)], 1u);
    return b;
}
DI void xcd_barrier_complete(unsigned* bar, unsigned x, unsigned& nloc, unsigned& nx) {
    const unsigned G = gridDim.x * gridDim.y * gridDim.z;
    unsigned sum, cnt, mine, sp = 0u;
    for (;;) {
        sum = 0u; cnt = 0u; mine = 0u;
#pragma unroll
        for (unsigned j = 0; j < 16; ++j) { const unsigned c = xb_ld(&bar[XB_XCNT(j)]); sum += c; cnt += (c > 0u) ? 1u : 0u; mine = (j == x) ? c : mine; }
        if (sum == G) break;
        __builtin_amdgcn_s_sleep(1);
        if ((++sp & 255u) == 0u) { if (xb_ld(&bar[XB_TMO])) break; if (sp > XB_SPIN_CAP) { atomicAdd(&bar[XB_TMO], 1u); break; } }
    }
    nloc = mine > 0u ? mine : 1u; nx = cnt > 0u ? cnt : 1u;
}
DI void xcd_barrier(const XcdBarrier& b) {
    asm volatile("s_waitcnt vmcnt(0)" ::: "memory");
    __syncthreads();
    if (my_tid() == 0) {
        unsigned* bar = b.bar;
        __builtin_amdgcn_s_waitcnt(0);
        unsigned nloc = b.st[0], nx = b.st[1];
        if (nloc == 0u) { xcd_barrier_complete(bar, b.x, nloc, nx); b.st[0] = nloc; b.st[1] = nx; }
        const unsigned old = xb_add(&bar[XB_XSUB(b.x)], 1u);
        const unsigned gen = old / nloc;
        if (old + 1u == (gen + 1u) * nloc) {
            __builtin_amdgcn_fence(__ATOMIC_RELEASE, "agent");
            asm volatile("s_waitcnt vmcnt(0)" ::: "memory");
            const unsigned og = xb_add(&bar[XB_TOP], 1u);
            const unsigned tg = og / nx;
            if (og + 1u == (tg + 1u) * nx) xb_add(&bar[XB_TOPGEN], 1u);
            else XB_SPIN(xb_ld(&bar[XB_TOPGEN]) == tg, bar);
            __builtin_amdgcn_fence(__ATOMIC_ACQUIRE, "agent");
            xb_add(&bar[XB_XGEN(b.x)], 1u);
            asm volatile("s_waitcnt vmcnt(0)" ::: "memory");
        } else {
            XB_SPIN(xb_ld(&bar[XB_XGEN(b.x)]) == gen, bar);
            __builtin_amdgcn_fence(__ATOMIC_ACQUIRE, "agent");
            asm volatile("s_waitcnt vmcnt(0)" ::: "memory");
        }
    }
    __syncthreads();
}

constexpr int LDS_BYTES = 131072 + 4096;
constexpr int NPH = 23;

__global__ void __launch_bounds__(512, 2) mega(Args a) {
    LAS unsigned char* lds = (LAS unsigned char*)lds_raw;
    if ((threadIdx.x & 63) == 0) *(volatile LAS int*)(lds + TIDTAB_OFF + hw_wave_slot() * 4) = (int)(threadIdx.x >> 6);
    __syncthreads();
    volatile LAS unsigned* bst = (volatile LAS unsigned*)(lds + 131072 + 1024);
    XcdBarrier xbar; xbar.bar = (unsigned*)(a.ws + OFF_BAR); xbar.x = 0; xbar.st = bst;
    if (a.ph_hi - a.ph_lo > 1) { if (my_tid() == 0) { bst[0] = 0u; bst[1] = 0u; } __syncthreads(); xbar = xcd_barrier_post((unsigned*)(a.ws + OFF_BAR), bst); }
    for (int it = a.ph_lo; it < a.ph_hi; ++it) {
        const int ph = it < 0 ? it + PROBE_PRE : it; const bool pre = it < 0; (void)pre;
        unsigned char* ws = a.ws; asm volatile("" : "+s"(ws));
        int G = gridDim.x, bid = blockIdx.x; asm volatile("" : "+s"(G), "+s"(bid));
        const int vcu = (G % 8 == 0) ? (bid & 7) * (G >> 3) + (bid >> 3) : bid;
        bf16_t* XN = (bf16_t*)(ws + OFF_XN); bf16_t* P = (bf16_t*)(ws + OFF_P); bf16_t* Qm = (bf16_t*)(ws + OFF_QM); bf16_t* KV = (bf16_t*)(ws + OFF_KV);
        bf16_t* RS = (bf16_t*)(ws + OFF_RS); bf16_t* PV = (bf16_t*)(ws + OFF_PV); bf16_t* LEb = (bf16_t*)(ws + OFF_LE); bf16_t* Xp = (bf16_t*)(ws + OFF_XP);
        const float2* ropeH = (const float2*)(ws + OFF_ROPEH); const float2* ropeR = (const float2*)(ws + OFF_ROPER);
        float* SSQ = (float*)(ws + OFF_SSQ);
        if (ph == 0) {
            int tid = my_tid(); asm volatile("" : "+v"(tid));
            for (int e = bid * 512 + tid; e < SEQ * 48; e += G * 512) {
                if (e < SEQ * 32) { const int pos = e >> 5, i = e & 31; const float inv = exp2f(-(float)i * (13.287712379549449f / 32.f)); float sn, cs; sincosf((float)pos * inv, &sn, &cs); ((float2*)(ws + OFF_ROPEH))[e] = make_float2(cs, sn); }
                else { const int e2 = e - SEQ * 32, pos = e2 >> 4, i = e2 & 15; const float inv = exp2f(-(float)i * (13.287712379549449f / 16.f)); float sn, cs; sincosf((float)pos * inv, &sn, &cs); ((float2*)(ws + OFF_ROPER))[e2] = make_float2(cs, sn); }
            }
            s5_tables(a, 0, lds);
            __syncthreads();
            prep_weights(a, 0, lds);
            norm_rows_first(a.in[0], a.in[1], XN);
        } else {
            const int l = (ph - 1) / 11, sp0 = (ph - 1) % 11; const int sp = sp0 < 2 ? sp0 : sp0 - 1;
            float* ssq_q = SSQ; float* ssq_kv = SSQ + (size_t)8 * M; float* ssq_z = SSQ + (size_t)16 * M; float* ssq_f = SSQ + (size_t)32 * M;
            if (sp0 == 2) {
                int tid = my_tid(); asm volatile("" : "+v"(tid));
                if (tid < 64) for (int pair = bid; pair < 256; pair += G) s5_scan(LEb, Xp, (const float*)(ws + OFF_AT), pair, tid);
                for (int tt = bid * 512 + tid; tt < 131072; tt += G * 512) ret_prefix(RS, PV, tt);
            } else if (sp == 0) {
                eng::PlainSched S{(const char*)XN, (const char*)(ws + W_IN), 2048, 2048, 16, 128, 13, G, bid, 128, (size_t)256 * 2048};
                EpiInProj E{P, ropeH, ropeR, ssq_q, ssq_kv};
                eng::gemm_phase(lds, S, E);
            } else if (sp == 1) {
                if (!(pre && (PROBE_SKIP & 8))) { eng::PlainSched S{(const char*)(P + C_CQ), (const char*)(ws + W_UQ), PP * 2, 512, 4, 128, 3, G, bid, 128, (size_t)256 * PP * 2}; EpiQup E{Qm, ropeR, ssq_q}; eng::gemm_phase(lds, S, E); }
                if (!(pre && (PROBE_SKIP & 8))) { eng::PlainSched S{(const char*)(P + C_CKV), (const char*)(ws + W_UKV), PP * 2, 256, 2, 128, 4, G, bid, 128, (size_t)256 * PP * 2}; EpiKVup E{KV, ssq_kv}; eng::gemm_phase(lds, S, E); }
                if (!(pre && (PROBE_SKIP & 16))) { S5StateSched S{(const char*)P, (const char*)(ws + OFF_WST), G, bid}; EpiLE E{LEb}; eng::gemm_phase(lds, S, E); }
                if (!(pre && (PROBE_SKIP & 32))) for (int u = bid; u < 1024; u += G) ret_state_unit(lds, P, RS, u);
                __syncthreads();
                const float* sinks = a.in[6] + l * 8;
                if (!(pre && (PROBE_SKIP & 64))) for (int u = vcu; u < 1024; u += G) { const int hd = (u >> 4) & 7; attn_unit<1>(lds, u >> 7, hd, u & 15, P, Qm, KV, sinks[hd] * LOG2E); }
            } else if (sp == 2) {
                if (!(pre && (PROBE_SKIP & 1))) for (int u = vcu; u < 1024; u += G) { const int i = u >> 8, v = u & 255, bh = v >> 2, s = v & 3; const int qb = i == 0 ? s : i == 1 ? 7 - s : i == 2 ? 8 + s : 15 - s;
                    attn_unit<0>(lds, bh >> 3, bh & 7, qb, P, Qm, KV, 0.f); }
                if (!(pre && (PROBE_SKIP & 2))) for (int u = bid; u < 1024; u += G) ret_out_unit(lds, P, PV, u);
                __syncthreads();
                if (!(pre && (PROBE_SKIP & 4))) { S5OutSched S{(const char*)P, (const char*)Xp, (const char*)(ws + OFF_TZ), (const char*)(ws + OFF_MC), G, bid}; EpiS5Out E{P, a.in[14] + l * 512}; eng::gemm_phase(lds, S, E); }
            } else if (sp == 3) {
                GluSched S{(const char*)P, (const char*)(ws + W_GLU), G, bid};
                EpiGlu E{P}; eng::gemm_phase(lds, S, E);
            } else if (sp == 4) {
                MergeSched S{(const char*)XN, (const char*)(ws + W_GATE), (const char*)(ws + W_BR), (const char*)P, (const char*)Qm, G, bid};
                u32x2* scr = (u32x2*)(ws + OFF_SCR) + (size_t)bid * 4 * 16 * 512;
                EpiMerge E{KV, scr}; eng::gemm_phase(lds, S, E);
            } else if (sp == 5) {
                eng::PlainSched S{(const char*)KV, (const char*)(ws + W_OUT), 2048, 2048, 16, 128, 4, G, bid, 128, (size_t)256 * 2048};
                EpiZ E{P, ssq_z}; eng::gemm_phase(lds, S, E);
            } else if (sp == 6) {
                if (l == 0) norm_rows_res<false, true>(a.in[0], P, ssq_z, a.in[2] + l * DM, KV, a.in[3] + l * DM, XN);
                else norm_rows_res<true, true>(a.out, P, ssq_z, a.in[2] + l * DM, KV, a.in[3] + l * DM, XN);
            } else if (sp == 7) {
                eng::PlainSched S{(const char*)XN, (const char*)(ws + W_FF1), 2048, 2048, 16, 128, 16, G, bid, 128, (size_t)256 * 2048};
                EpiFF1 E{P}; eng::gemm_phase(lds, S, E);
            } else if (sp == 8) {
                eng::PlainSched S{(const char*)P, (const char*)(ws + W_FF2), 128, HP * 2, 64, 128, 4, G, bid, 32768, (size_t)64 * 32768};
                EpiZ E{XN, ssq_f}; eng::gemm_phase(lds, S, E);
            } else {
                if (l + 1 < 2) norm_rows_res<true, true>(KV, XN, ssq_f, a.in[4] + l * DM, a.out, a.in[1] + (l + 1) * DM, XN);
                else norm_rows_res<true, false>(KV, XN, ssq_f, a.in[4] + l * DM, a.out, nullptr, XN);
                if (l + 1 < 2) { __syncthreads(); s5_tables(a, l + 1, lds); __syncthreads(); prep_weights(a, l + 1, lds); }
            }
        }
        if (it + 1 < a.ph_hi) { if (a.ph_hi > NPH) { __threadfence(); cg::this_grid().sync(); }
            xcd_barrier(xbar); }
    }
}

extern "C" void kernel_launch(void* const* d_in, const int* in_sizes, int n_in, void* d_out, int out_size, void* d_ws, size_t ws_size, hipStream_t stream) {
    static int grid = 0;
    if (grid == 0) {
        if (n_in != 24 || ws_size < WS_NEED) { fprintf(stderr, "kernel_launch: unexpected n_in %d / ws_size %zu\n", n_in, ws_size); grid = -1; return; }
        int dev = 0, cus = 0, per_cu = 0;
        hipGetDevice(&dev); hipDeviceGetAttribute(&cus, hipDeviceAttributeMultiprocessorCount, dev);
        hipFuncSetAttribute((const void*)mega, hipFuncAttributeMaxDynamicSharedMemorySize, LDS_BYTES);
        hipOccupancyMaxActiveBlocksPerMultiprocessor(&per_cu, (const void*)mega, 512, LDS_BYTES);
        if (per_cu < 1) { fprintf(stderr, "kernel_launch: occupancy query returned %d\n", per_cu); per_cu = 1; }
        (void)hipGetLastError();
        grid = cus;
    }
    if (grid < 0) return;
    Args a{};
    for (int i = 0; i < 24; ++i) a.in[i] = (const float*)d_in[i];
    a.out = (float*)d_out; a.ws = (unsigned char*)d_ws;
#if N_LAUNCH_MODE == 1
    hipMemsetAsync((char*)d_ws + OFF_BAR, 0, 16384, stream);
    a.ph_lo = -PROBE_PRE; a.ph_hi = NPH;
    void* args[] = {&a};
    hipError_t e = hipLaunchCooperativeKernel((const void*)mega, dim3(grid), dim3(512), args, LDS_BYTES, stream);
    if (e != hipSuccess) fprintf(stderr, "cooperative launch failed: %s (grid %d)\n", hipGetErrorString(e), grid);
#else
    for (int ph = 0; ph < NPH; ++ph) { a.ph_lo = ph; a.ph_hi = ph + 1; hipLaunchKernelGGL(mega, dim3(grid), dim3(512), LDS_BYTES, stream, a); }
#endif
}
```
